# Optimizing an MI355X kernel written in HIP

```python
import jax, jax.numpy as jnp
from jax import lax
import numpy as np

D_MODEL = 2048
BATCH = 1
SEQ = 8192
DEPTH = 1

GRID_W = 64
CTX_LEN = 256
MIX_WIDTH = D_MODEL
HG_HEAD_DIM = 128
HG_WIDTH = MIX_WIDTH // 2
HG_HEADS = HG_WIDTH // HG_HEAD_DIM
NA_HEAD_DIM = 128
NA_WIDTH = MIX_WIDTH - HG_WIDTH
NA_HEADS = NA_WIDTH // NA_HEAD_DIM
NA_MAX_KH = 8
NA_KW = 16
HG_COLS = 5 * HG_WIDTH
NA_COLS = 3 * NA_WIDTH
IN_COLS = HG_COLS + NA_COLS
D_FF = 256 * ((8 * D_MODEL // 3 + 255) // 256)
HG_CHUNK = 64
ROPE_BASE = 10000.0
N_MOD = 9
EPS = 1e-6

kernel_name = 'hymba_hgrn2_natten_macaron_dit'

F32 = jnp.float32


def rmsnorm(x, w):
    xf = x.astype(F32)
    return xf * lax.rsqrt(jnp.mean(xf * xf, axis=-1, keepdims=True) + EPS) * w.astype(F32)


def modulate(h, shift, scale):
    return h * (1.0 + scale) + shift


def swiglu(h, w_gate, w_up, w_down):
    return (jax.nn.silu(h @ w_gate) * (h @ w_up)) @ w_down


def adaln_half_ffn(h, norm_gain, shift, scale, gate, w_gate, w_up, w_down):
    u = modulate(rmsnorm(h, norm_gain), shift, scale)
    return h + 0.5 * gate * swiglu(u, w_gate, w_up, w_down)


def axial_rope_tables(n_tokens):
    t = jnp.arange(n_tokens)
    row = (t // GRID_W).astype(F32)
    col = (t % GRID_W).astype(F32)
    quarter = NA_HEAD_DIM // 4
    inv = ROPE_BASE ** (-jnp.arange(quarter, dtype=F32) / quarter)
    ang_r = row[:, None] * inv[None, :]
    ang_c = col[:, None] * inv[None, :]
    ang = jnp.concatenate([ang_r, ang_r, ang_c, ang_c], axis=-1)
    return jnp.cos(ang)[:, None, :], jnp.sin(ang)[:, None, :]


def apply_axial_rope(x, cos, sin):
    def rot_half(a):
        a1, a2 = jnp.split(a, 2, axis=-1)
        return jnp.concatenate([-a2, a1], axis=-1)
    xr, xc = jnp.split(x, 2, axis=-1)
    return x * cos + jnp.concatenate([rot_half(xr), rot_half(xc)], axis=-1) * sin


def gla_chunk_scan(q, k, v, log_f, s0):
    B, T, H, DK = q.shape
    DV = v.shape[-1]
    n = T // HG_CHUNK

    def chunks(a):
        return a.reshape(B, n, HG_CHUNK, H, a.shape[-1]).transpose(1, 0, 3, 2, 4)

    lower = jnp.tril(jnp.ones((HG_CHUNK, HG_CHUNK), dtype=bool))[:, :, None]

    def step(S, blk):
        qc, kc, vc, gc = blk
        b = jnp.cumsum(gc, axis=2)
        rel = jnp.exp(jnp.where(lower, b[:, :, :, None, :] - b[:, :, None, :, :], -jnp.inf))
        scores = jnp.einsum('bhtd,bhsd,bhtsd->bhts', qc, kc, rel)
        o = (jnp.einsum('bhts,bhsv->bhtv', scores, vc)
             + jnp.einsum('bhtd,bhdv->bhtv', qc * jnp.exp(b), S))
        b_end = b[:, :, -1:, :]
        S = (jnp.exp(b_end[:, :, 0, :, None]) * S
             + jnp.einsum('bhsd,bhsv->bhdv', kc * jnp.exp(b_end - b), vc))
        return S, o

    s_fin, o = lax.scan(step, s0, (chunks(q), chunks(k), chunks(v), chunks(log_f)))
    return o.transpose(1, 0, 3, 2, 4).reshape(B, T, H, DV), s_fin


def flip_time(a, rev):
    return a[:, ::-1] if rev else a


def hgrn2_group(p_lat, p_ctx, lb, norm_w, need_ctx):
    def prepare(p):
        B, T, _ = p.shape
        q, f_fw, f_bw, i, g = jnp.split(p.astype(F32), 5, axis=-1)
        hd = lambda a: a.reshape(B, T, HG_HEADS, HG_HEAD_DIM)
        dirs = []
        for f_raw, lb_d in ((f_fw, lb[0]), (f_bw, lb[1])):
            f = lb_d + (1.0 - lb_d) * jax.nn.sigmoid(f_raw)
            dirs.append((hd(jnp.log(f)), hd(1.0 - f)))
        return hd(jax.nn.silu(q)), hd(i), g, dirs

    q_l, v_l, g_l, dirs_l = prepare(p_lat)
    q_c, v_c, g_c, dirs_c = prepare(p_ctx)
    B = p_lat.shape[0]
    s0 = jnp.zeros((B, HG_HEADS, HG_HEAD_DIM, HG_HEAD_DIM), F32)
    outs_l, outs_c = [], []
    for (logf_l, k_l), (logf_c, k_c), rev in zip(dirs_l, dirs_c, (False, True)):
        oc, s_ctx = gla_chunk_scan(flip_time(q_c, rev), flip_time(k_c, rev), flip_time(v_c, rev),
                                   flip_time(logf_c, rev), s0)
        ol, _ = gla_chunk_scan(flip_time(q_l, rev), flip_time(k_l, rev), flip_time(v_l, rev),
                               flip_time(logf_l, rev), s_ctx)
        outs_l.append(flip_time(ol, rev))
        outs_c.append(flip_time(oc, rev))

    def readout(o, g):
        Bo, T = o.shape[0], o.shape[1]
        return rmsnorm(o, norm_w).reshape(Bo, T, HG_WIDTH) * jax.nn.silu(g)

    y_l = readout(outs_l[0] + outs_l[1], g_l)
    if not need_ctx:
        return y_l, None
    return y_l, readout(outs_c[0] + outs_c[1], g_c)


def neighbourhood_group(p_lat, p_ctx, rpb, cos, sin, rows, need_ctx):
    B, T, _ = p_lat.shape
    scale = NA_HEAD_DIM ** -0.5
    heads = lambda a: a.reshape(a.shape[0], a.shape[1], NA_HEADS, NA_HEAD_DIM)
    q_l, k_l, v_l = (heads(a) for a in jnp.split(p_lat.astype(F32), 3, axis=-1))
    q_c, k_c, v_c = (heads(a) for a in jnp.split(p_ctx.astype(F32), 3, axis=-1))
    q_l = apply_axial_rope(q_l, cos, sin) * scale
    k_l = apply_axial_rope(k_l, cos, sin)

    kh = min(NA_MAX_KH, rows)
    grid = lambda a: a.reshape(B, rows, GRID_W, NA_HEADS, NA_HEAD_DIM)
    q_g, k_g, v_g = grid(q_l), grid(k_l), grid(v_l)
    r = jnp.arange(rows)
    row_start = jnp.clip(r - kh // 2, 0, rows - kh)
    key_rows = row_start[:, None] + jnp.arange(kh)[None, :]
    k_win = k_g[:, key_rows]
    v_win = v_g[:, key_rows]
    col = jnp.arange(GRID_W)
    col_start = jnp.clip(col - NA_KW // 2, 0, GRID_W - NA_KW)
    col_in = (col[None, :] >= col_start[:, None]) & (col[None, :] < col_start[:, None] + NA_KW)
    dr = key_rows - r[:, None] + (NA_MAX_KH - 1)
    dc = jnp.clip(col[None, :] - col[:, None], 1 - NA_KW, NA_KW - 1) + (NA_KW - 1)
    bias = rpb[:, dr[:, None, :, None], dc[None, :, None, :]].astype(F32)

    s_win = jnp.einsum('brchd,brkjhd->bhrckj', q_g, k_win) + bias
    s_win = jnp.where(col_in[:, None, :], s_win, -jnp.inf)
    n_win = kh * GRID_W
    s_win = s_win.reshape(B, NA_HEADS, rows, GRID_W, n_win)
    s_ctx = jnp.einsum('brchd,bkhd->bhrck', q_g, k_c)
    probs = jax.nn.softmax(jnp.concatenate([s_win, s_ctx], axis=-1), axis=-1)
    p_win = probs[..., :n_win].reshape(B, NA_HEADS, rows, GRID_W, kh, GRID_W)
    o_l = (jnp.einsum('bhrckj,brkjhd->brchd', p_win, v_win)
           + jnp.einsum('bhrck,bkhd->brchd', probs[..., n_win:], v_c))
    o_l = o_l.reshape(B, T, NA_WIDTH)
    if not need_ctx:
        return o_l, None
    p_cc = jax.nn.softmax(jnp.einsum('bqhd,bkhd->bhqk', q_c * scale, k_c), axis=-1)
    o_c = jnp.einsum('bhqk,bkhd->bqhd', p_cc, v_c).reshape(B, p_ctx.shape[1], NA_WIDTH)
    return o_l, o_c


def hybrid_mixer(u_lat, u_ctx, w_in, lb, hg_norm_w, rpb, cos, sin, rows, need_ctx):
    p_lat = u_lat @ w_in
    p_ctx = u_ctx @ w_in
    hg_l, hg_c = hgrn2_group(p_lat[..., :HG_COLS], p_ctx[..., :HG_COLS], lb, hg_norm_w, need_ctx)
    na_l, na_c = neighbourhood_group(p_lat[..., HG_COLS:], p_ctx[..., HG_COLS:], rpb, cos, sin, rows, need_ctx)
    mix_l = jnp.concatenate([hg_l, na_l], axis=-1)
    mix_c = jnp.concatenate([hg_c, na_c], axis=-1) if need_ctx else None
    return mix_l, mix_c


def setup_inputs(seed: int = 0) -> dict:
    key = jax.random.key(seed)
    ks = jax.random.split(key, 20)
    nrm = lambda k, shape, s: s * jax.random.normal(k, shape, F32)
    return {
        'x': nrm(ks[0], (BATCH, SEQ, D_MODEL), 1.0),
        'c': nrm(ks[1], (BATCH, D_MODEL), 1.0),
        'ctx': nrm(ks[2], (BATCH, CTX_LEN, D_MODEL), 1.0),
        'c_ctx': nrm(ks[3], (D_MODEL,), 1.0),
        'w_mod': nrm(ks[4], (DEPTH, D_MODEL, N_MOD * D_MODEL), 0.3 * D_MODEL ** -0.5),
        'b_mod': nrm(ks[5], (DEPTH, N_MOD * D_MODEL), 0.01),
        'norm_w': 1.0 + nrm(ks[6], (DEPTH, 3, D_MODEL), 0.05),
        'ffn1_w_gate': nrm(ks[7], (DEPTH, D_MODEL, D_FF), D_MODEL ** -0.5),
        'ffn1_w_up': nrm(ks[8], (DEPTH, D_MODEL, D_FF), D_MODEL ** -0.5),
        'ffn1_w_down': nrm(ks[9], (DEPTH, D_FF, D_MODEL), D_FF ** -0.5),
        'w_in': nrm(ks[10], (DEPTH, D_MODEL, IN_COLS), D_MODEL ** -0.5),
        'hg_lb_logits': nrm(ks[11], (2, DEPTH + 1, HG_WIDTH), 1.0),
        'hg_norm_w': 1.0 + nrm(ks[12], (DEPTH, HG_HEAD_DIM), 0.05),
        'na_rpb': nrm(ks[13], (DEPTH, NA_HEADS, 2 * NA_MAX_KH - 1, 2 * NA_KW - 1), 0.02),
        'w_out': nrm(ks[14], (DEPTH, MIX_WIDTH, D_MODEL), MIX_WIDTH ** -0.5),
        'ffn2_w_gate': nrm(ks[15], (DEPTH, D_MODEL, D_FF), D_MODEL ** -0.5),
        'ffn2_w_up': nrm(ks[16], (DEPTH, D_MODEL, D_FF), D_MODEL ** -0.5),
        'ffn2_w_down': nrm(ks[17], (DEPTH, D_FF, D_MODEL), D_FF ** -0.5),
        'final_norm_w': 1.0 + nrm(ks[18], (D_MODEL,), 0.05),
    }


def reference(x, c, ctx, c_ctx, w_mod, b_mod, norm_w, ffn1_w_gate, ffn1_w_up, ffn1_w_down,
              w_in, hg_lb_logits, hg_norm_w, na_rpb, w_out, ffn2_w_gate, ffn2_w_up, ffn2_w_down,
              final_norm_w):
    B, T, D = x.shape
    rows = T // GRID_W
    cos, sin = axial_rope_tables(T)
    lb_all = jnp.cumsum(jax.nn.softmax(hg_lb_logits.astype(F32), axis=1), axis=1)
    h_l, h_c = x, ctx
    for layer in range(DEPTH):
        last = layer == DEPTH - 1
        m_l = (jax.nn.silu(c) @ w_mod[layer] + b_mod[layer]).reshape(B, N_MOD, 1, D)
        m_c = (jax.nn.silu(c_ctx) @ w_mod[layer] + b_mod[layer]).reshape(1, N_MOD, 1, D)
        ffn1 = (ffn1_w_gate[layer], ffn1_w_up[layer], ffn1_w_down[layer])
        ffn2 = (ffn2_w_gate[layer], ffn2_w_up[layer], ffn2_w_down[layer])
        h_l = adaln_half_ffn(h_l, norm_w[layer, 0], m_l[:, 0], m_l[:, 1], m_l[:, 2], *ffn1)
        h_c = adaln_half_ffn(h_c, norm_w[layer, 0], m_c[:, 0], m_c[:, 1], m_c[:, 2], *ffn1)
        u_l = modulate(rmsnorm(h_l, norm_w[layer, 1]), m_l[:, 3], m_l[:, 4])
        u_c = modulate(rmsnorm(h_c, norm_w[layer, 1]), m_c[:, 3], m_c[:, 4])
        mix_l, mix_c = hybrid_mixer(u_l, u_c, w_in[layer], lb_all[:, layer], hg_norm_w[layer],
                                    na_rpb[layer], cos, sin, rows, not last)
        h_l = h_l + m_l[:, 5] * (mix_l @ w_out[layer])
        if not last:
            h_c = h_c + m_c[:, 5] * (mix_c @ w_out[layer])
            h_c = adaln_half_ffn(h_c, norm_w[layer, 2], m_c[:, 6], m_c[:, 7], m_c[:, 8], *ffn2)
        h_l = adaln_half_ffn(h_l, norm_w[layer, 2], m_l[:, 6], m_l[:, 7], m_l[:, 8], *ffn2)
    return rmsnorm(h_l, final_norm_w)
```

```cpp
#include <hip/hip_runtime.h>
#include <cstdio>
#include <cstdint>
#include <cmath>
namespace pg8 {
#define PG8_LAS __attribute__((address_space(3)))
typedef unsigned short bf16_t;
typedef short bf16x8 __attribute__((ext_vector_type(8)));
typedef float f32x4 __attribute__((ext_vector_type(4)));
typedef unsigned u32x4 __attribute__((ext_vector_type(4)));
constexpr int BM = 256, BK = 64, HALF = 128, HTB = HALF * BK * 2  , STAGE_BYTES = 8 * HTB, NXCD = 8, WGM = 8;

__host__ __device__ __forceinline__ int lds_byte(int r, int c) { const int st = (r >> 4) * 2 + (c >> 5), rr = r & 15, cc = c & 31, ob = rr * 64 + cc * 2; return st * 1024 + (ob ^ (((ob >> 9) & 1) << 5)); }
__host__ __device__ __forceinline__ void stage_rc(int b, int& R, int& C) { const int st = b / 1024, sb = b % 1024, swz = sb ^ (((sb >> 9) & 1) << 5); R = (st >> 1) * 16 + swz / 64; C = (st & 1) * 32 + (swz % 64) / 2; }
__host__ __device__ __forceinline__ int perm32(int rho) { const int n = rho >> 4, i = rho & 15; return 8 * (i >> 2) + 4 * n + (i & 3); }

struct Unit { int pm, pn; };
struct Gemm { const bf16_t* A; const bf16_t* Bt; int M, N, K; };

struct StaticOrder {
    int nM, nN, nwg, G, c;
    __host__ __device__ void init(int M, int N, int G_, int c_) { nM = M / BM; nN = N / BM; nwg = nM * nN; G = G_; c = c_; }
    __host__ __device__ bool next(int i, Unit& u) const {
        const long L = (long)i * G + c; if (L >= nwg) return false;
        int wgid = (int)L; { const int q = nwg / NXCD, r = nwg % NXCD, xcd = wgid % NXCD, off = wgid / NXCD; wgid = (xcd < r ? xcd * (q + 1) : r * (q + 1) + (xcd - r) * q) + off; }
        const int nig = WGM * nN, gid = wgid / nig, fm = gid * WGM, gsz = (nM - fm) < WGM ? (nM - fm) : WGM;
        u.pm = fm + ((wgid % nig) % gsz); u.pn = (wgid % nig) / gsz; return true;
    }
    __device__ __forceinline__ void a_ready(const Unit&) const {}
    __device__ __forceinline__ void done(const Unit&) const {}
};

__device__ __forceinline__ unsigned cvt_pk_bf16(float lo, float hi) { unsigned r; asm volatile("v_cvt_pk_bf16_f32 %0, %1, %2" : "=v"(r) : "v"(lo), "v"(hi)); return r; }
typedef float f32x2 __attribute__((ext_vector_type(2)));
__device__ __forceinline__ float sigmoid_f(float v) { return __builtin_amdgcn_rcpf(1.0f + __builtin_amdgcn_exp2f(-1.44269504089f * v)); }
__device__ __forceinline__ float silu_f(float v) { return v * sigmoid_f(v); }

struct EpiSwiglu {
    static constexpr bool PERM = true, AFTER_DRAIN = false;
    bf16_t* H; int ldh;
    __device__ __forceinline__ void operator()(const f32x4 (&acc)[2][2][4][2], const Unit& u, int wr, int wc, int fr, int fq) const {
        const int row0 = u.pm * BM + wr * 64 + fr, col0 = u.pn * HALF + wc * 32 + 8 * fq;
#pragma unroll
        for (int ai = 0; ai < 2; ++ai)
#pragma unroll
            for (int m = 0; m < 4; ++m) { bf16_t* rowp = H + (size_t)(row0 + ai * HALF + m * 16) * ldh + col0;
                const f32x4 g0 = acc[ai][0][m][0], g1 = acc[ai][0][m][1], u0 = acc[ai][1][m][0], u1 = acc[ai][1][m][1];
                u32x4 w; w.x = cvt_pk_bf16(silu_f(g0[0]) * u0[0], silu_f(g0[1]) * u0[1]); w.y = cvt_pk_bf16(silu_f(g0[2]) * u0[2], silu_f(g0[3]) * u0[3]);
                w.z = cvt_pk_bf16(silu_f(g1[0]) * u1[0], silu_f(g1[1]) * u1[1]); w.w = cvt_pk_bf16(silu_f(g1[2]) * u1[2], silu_f(g1[3]) * u1[3]);
                *(u32x4*)rowp = w; }
    }
};

struct EpiResid {
    static constexpr bool PERM = false, AFTER_DRAIN = false;
    const float* base_l; const float* base_c; float* out_l; float* out_c; const float* gate_l; const float* gate_c; float coef;
    __device__ __forceinline__ void operator()(const f32x4 (&acc)[2][2][4][2], const Unit& u, int wr, int wc, int fr, int fq) const {
        const bool isc = u.pm >= 32;
        const float* base = isc ? base_c : base_l; float* out = isc ? out_c : out_l; const float* gate = isc ? gate_c : gate_l;
        const int row0 = (isc ? 0 : u.pm * BM) + wr * 64 + fr, col0 = u.pn * BM + wc * 32 + 4 * fq;
        f32x4 gv[2][2];
#pragma unroll
        for (int bj = 0; bj < 2; ++bj)
#pragma unroll
            for (int n = 0; n < 2; ++n) gv[bj][n] = *(const f32x4*)(gate + col0 + bj * HALF + n * 16) * coef;
#pragma unroll
        for (int ai = 0; ai < 2; ++ai)
#pragma unroll
            for (int m = 0; m < 4; ++m) { const size_t off = (size_t)(row0 + ai * HALF + m * 16) * 2048 + col0;
#pragma unroll
                for (int bj = 0; bj < 2; ++bj)
#pragma unroll
                    for (int n = 0; n < 2; ++n) { const f32x4 b = *(const f32x4*)(base + off + bj * HALF + n * 16); *(f32x4*)(out + off + bj * HALF + n * 16) = b + gv[bj][n] * acc[ai][bj][m][n]; } }
    }
};

struct EpiWin {
    static constexpr bool PERM = true, AFTER_DRAIN = false;
    bf16_t* HQ; bf16_t* HK0; bf16_t* HK1; float* LF0; float* LF1; bf16_t* HV; bf16_t* HG; bf16_t* NQ; bf16_t* NK; bf16_t* NV;
    const float* lb;
    const float* ropeT;
    __device__ __forceinline__ void st8(bf16_t* p, const f32x4 a, const f32x4 b) const { u32x4 w; w.x = cvt_pk_bf16(a[0], a[1]); w.y = cvt_pk_bf16(a[2], a[3]); w.z = cvt_pk_bf16(b[0], b[1]); w.w = cvt_pk_bf16(b[2], b[3]); *(u32x4*)p = w; }
    __device__ __forceinline__ void operator()(const f32x4 (&acc)[2][2][4][2], const Unit& u, int wr, int wc, int fr, int fq) const {
        const int grp = u.pn >> 2, row0 = u.pm * BM + wr * 64 + fr, gc0 = (u.pn & 3) * BM + wc * 32 + 8 * fq;
        if (grp == 0 || grp == 3 || grp == 4 || grp == 7) {
            bf16_t* O = grp == 0 ? HQ : (grp == 3 ? HV : (grp == 4 ? HG : NV)); const bool act = (grp == 0 || grp == 4);
#pragma unroll
            for (int ai = 0; ai < 2; ++ai)
#pragma unroll
                for (int m = 0; m < 4; ++m)
#pragma unroll
                    for (int bj = 0; bj < 2; ++bj) { f32x4 a = acc[ai][bj][m][0], b = acc[ai][bj][m][1];
                        if (act) { a = (f32x4){silu_f(a[0]), silu_f(a[1]), silu_f(a[2]), silu_f(a[3])}; b = (f32x4){silu_f(b[0]), silu_f(b[1]), silu_f(b[2]), silu_f(b[3])}; }
                        st8(O + (size_t)(row0 + ai * HALF + m * 16) * 1024 + gc0 + bj * HALF, a, b); }
        } else if (grp == 1 || grp == 2) {
            const int d = grp - 1; bf16_t* K = d ? HK1 : HK0; float* L = d ? LF1 : LF0;
#pragma unroll
            for (int bj = 0; bj < 2; ++bj) { const f32x4 l0 = *(const f32x4*)(lb + d * 1024 + gc0 + bj * HALF), l1 = *(const f32x4*)(lb + d * 1024 + gc0 + bj * HALF + 4);
#pragma unroll
                for (int ai = 0; ai < 2; ++ai)
#pragma unroll
                    for (int m = 0; m < 4; ++m) { const f32x4 a = acc[ai][bj][m][0], b = acc[ai][bj][m][1]; f32x4 ka, kb, la, lc;
#pragma unroll
                        for (int e = 0; e < 4; ++e) { const float sa = sigmoid_f(a[e]), sb = sigmoid_f(b[e]);
                            ka[e] = (1.0f - l0[e]) * (1.0f - sa); kb[e] = (1.0f - l1[e]) * (1.0f - sb);
                            la[e] = __logf(l0[e] + (1.0f - l0[e]) * sa); lc[e] = __logf(l1[e] + (1.0f - l1[e]) * sb); }
                        const size_t off = (size_t)(row0 + ai * HALF + m * 16) * 1024 + gc0 + bj * HALF;
                        st8(K + off, ka, kb); *(f32x4*)(L + off) = la; *(f32x4*)(L + off + 4) = lc; } }
        } else {
            bf16_t* O = grp == 5 ? NQ : NK; const float sc = grp == 5 ? 0.08838834764831845f : 1.0f;
            const int head = 2 * (u.pn & 3) + (wc >> 1), half = wc & 1, dcol = head * 128 + 64 * half + 8 * fq; const bool isc = u.pm >= 32;
#pragma unroll
            for (int ai = 0; ai < 2; ++ai)
#pragma unroll
                for (int m = 0; m < 4; ++m) { const int row = row0 + ai * HALF + m * 16; const int pos = half ? (row & 63) : ((row >> 6) & 127);
                    f32x4 c0 = (f32x4){1.f, 1.f, 1.f, 1.f}, c1 = c0, s0 = (f32x4){0.f, 0.f, 0.f, 0.f}, s1 = s0;
                    if (!isc) { const float* ct = ropeT + pos * 32 + 8 * fq; c0 = *(const f32x4*)ct; c1 = *(const f32x4*)(ct + 4); s0 = *(const f32x4*)(ct + 4096); s1 = *(const f32x4*)(ct + 4100); }
                    const f32x4 a0 = acc[ai][0][m][0], a1 = acc[ai][0][m][1], b0 = acc[ai][1][m][0], b1 = acc[ai][1][m][1];
                    bf16_t* p = O + (size_t)row * 1024 + dcol;
                    st8(p, (a0 * c0 - b0 * s0) * sc, (a1 * c1 - b1 * s1) * sc); st8(p + 32, (b0 * c0 + a0 * s0) * sc, (b1 * c1 + a1 * s1) * sc); }
        }
    }
};

template <class Epi, class Sched, bool ALIGN_EPI = false, bool SP2 = false>
__device__ __forceinline__ void gemm_phase(PG8_LAS unsigned char* lds, const Gemm g, const Sched& S, const Epi& E) {
    const int tid = threadIdx.x, wid = __builtin_amdgcn_readfirstlane(tid >> 6), lane = tid & 63, wr = wid >> 2, wc = wid & 3, fr = lane & 15, fq = lane >> 4;
    const int K = g.K, nt = K / BK;
    unsigned voffA[2], voffB[2];
#pragma unroll
    for (int i = 0; i < 2; ++i) { int R, C; stage_rc(tid * 16 + i * 8192, R, C); const int Rb = Epi::PERM ? ((R & ~31) + perm32(R & 31)) : R;
        voffA[i] = (unsigned)(R * K + C) * 2u; voffB[i] = (unsigned)(Rb * K + C) * 2u; }
    const size_t kstep = (size_t)(BK * 2);
    const size_t hstep = (size_t)HALF * K * 2;
    const size_t tstep = 2 * hstep;
    const unsigned ldsw = (unsigned)wid * 1024u;
    const int aoff = lds_byte(wr * 64 + fr, fq * 8), boff = lds_byte(wc * 32 + fr, fq * 8);
#define PG8_SA(b, h) (((b) * 2 + (h)) * HTB)
#define PG8_SB(b, h) ((4 + (b) * 2 + (h)) * HTB)
#define PG8_STAGE(bufoff, gbase, voff) do { _Pragma("unroll") for (int _i = 0; _i < 2; ++_i) \
        __builtin_amdgcn_global_load_lds((const unsigned*)((const char*)(gbase) + (voff)[_i]), (PG8_LAS unsigned*)(lds + (bufoff) + ldsw + _i * 8192), 16, 0, 0); } while (0)
#define PG8_LDA(dst, b, h) do { _Pragma("unroll") for (int m = 0; m < 4; ++m) _Pragma("unroll") for (int k = 0; k < 2; ++k) dst[m][k] = *(const PG8_LAS bf16x8*)(lds + PG8_SA(b, h) + aoff + m * 2048 + k * 1024); } while (0)
#define PG8_LDB(dst, b, h) do { _Pragma("unroll") for (int n = 0; n < 2; ++n) _Pragma("unroll") for (int k = 0; k < 2; ++k) dst[n][k] = *(const PG8_LAS bf16x8*)(lds + PG8_SB(b, h) + boff + n * 2048 + k * 1024); } while (0)
#define PG8_MMA(ai, bj, At, Bt) do { __builtin_amdgcn_s_setprio(1); _Pragma("unroll") for (int m = 0; m < 4; ++m) _Pragma("unroll") for (int n = 0; n < 2; ++n) _Pragma("unroll") for (int k = 0; k < 2; ++k) \
        acc[ai][bj][m][n] = __builtin_amdgcn_mfma_f32_16x16x32_bf16(Bt[n][k], At[m][k], acc[ai][bj][m][n], 0, 0, 0); __builtin_amdgcn_s_setprio(0); } while (0)
#define PG8_WAIT_V(n) asm volatile("s_waitcnt vmcnt(" #n ")" ::: "memory")
#define PG8_WAIT_L(n) asm volatile("s_waitcnt lgkmcnt(" #n ")" ::: "memory")
#define PG8_BAR __builtin_amdgcn_s_barrier()
#define PG8_SCHED __builtin_amdgcn_sched_barrier(0)
    Unit cur, nxt; int ui = 0;
    if (!S.next(0, cur)) return;
    f32x4 acc[2][2][4][2];
#pragma unroll
    for (int a = 0; a < 2; ++a)
#pragma unroll
        for (int b = 0; b < 2; ++b)
#pragma unroll
            for (int m = 0; m < 4; ++m)
#pragma unroll
                for (int n = 0; n < 2; ++n) acc[a][b][m][n] = (f32x4){0.f, 0.f, 0.f, 0.f};
    bf16x8 At[4][2], B0[2][2], B1[2][2];
    const char* cA = (const char*)g.A + (size_t)cur.pm * tstep; const char* cB = (const char*)g.Bt + (size_t)cur.pn * tstep;
    S.a_ready(cur);
    if constexpr (SP2) {
        PG8_STAGE(PG8_SB(0, 0), cB, voffB); PG8_STAGE(PG8_SB(0, 1), cB + hstep, voffB); PG8_STAGE(PG8_SA(0, 0), cA, voffA); PG8_STAGE(PG8_SA(0, 1), cA + hstep, voffA);
        if (wr == 1) PG8_BAR;
        PG8_WAIT_V(2); PG8_BAR;
        PG8_STAGE(PG8_SB(1, 0), cB + kstep, voffB); PG8_STAGE(PG8_SA(1, 0), cA + kstep, voffA); PG8_STAGE(PG8_SB(1, 1), cB + hstep + kstep, voffB);
        PG8_WAIT_V(6); PG8_BAR;
    } else {
        PG8_STAGE(PG8_SB(0, 0), cB, voffB); PG8_STAGE(PG8_SA(0, 0), cA, voffA); PG8_STAGE(PG8_SB(0, 1), cB + hstep, voffB); PG8_STAGE(PG8_SA(0, 1), cA + hstep, voffA);
        if (wr == 1) PG8_BAR;
        PG8_WAIT_V(4); PG8_BAR;
        PG8_STAGE(PG8_SB(1, 0), cB + kstep, voffB); PG8_STAGE(PG8_SA(1, 0), cA + kstep, voffA); PG8_STAGE(PG8_SB(1, 1), cB + hstep + kstep, voffB);
        PG8_WAIT_V(6); PG8_BAR;
    }
    for (;;) {
        const bool has_next = S.next(ui + 1, nxt);
        const char* nA = has_next ? (const char*)g.A + (size_t)nxt.pm * tstep : cA; const char* nB = has_next ? (const char*)g.Bt + (size_t)nxt.pn * tstep : cB;
        for (int t = 0; t < nt; t += 2) {
            const bool last = (t == nt - 2);
            const char* a1 = cA + (size_t)(t + 1) * kstep;
            const char* a2 = last ? nA : cA + (size_t)(t + 2) * kstep; const char* b2 = last ? nB : cB + (size_t)(t + 2) * kstep;
            const char* a3 = a2 + kstep; const char* b3 = b2 + kstep;
            if (last && has_next) S.a_ready(nxt);
            if constexpr (SP2) {
            PG8_LDB(B0, 0, 0); PG8_LDB(B1, 0, 1); PG8_SCHED; PG8_LDA(At, 0, 0); PG8_STAGE(PG8_SA(1, 1), a1 + hstep, voffA);
            PG8_WAIT_V(8); PG8_WAIT_L(0); PG8_BAR; PG8_MMA(0, 0, At, B0); PG8_MMA(0, 1, At, B1); PG8_BAR; PG8_SCHED;
            PG8_LDA(At, 0, 1); PG8_STAGE(PG8_SB(0, 0), b2, voffB); PG8_STAGE(PG8_SB(0, 1), b2 + hstep, voffB); PG8_STAGE(PG8_SA(0, 0), a2, voffA);
            PG8_WAIT_V(8); PG8_WAIT_L(0); PG8_BAR; PG8_MMA(1, 0, At, B0); PG8_MMA(1, 1, At, B1); PG8_BAR; PG8_SCHED;
            PG8_LDB(B0, 1, 0); PG8_LDB(B1, 1, 1); PG8_SCHED; PG8_LDA(At, 1, 0); PG8_STAGE(PG8_SA(0, 1), a2 + hstep, voffA);
            PG8_WAIT_V(8); PG8_WAIT_L(0); PG8_BAR; PG8_MMA(0, 0, At, B0); PG8_MMA(0, 1, At, B1); PG8_BAR; PG8_SCHED;
            PG8_LDA(At, 1, 1); PG8_STAGE(PG8_SB(1, 0), b3, voffB); PG8_STAGE(PG8_SB(1, 1), b3 + hstep, voffB); PG8_STAGE(PG8_SA(1, 0), a3, voffA);
            PG8_WAIT_V(8); PG8_WAIT_L(0); PG8_BAR; PG8_MMA(1, 0, At, B0); PG8_MMA(1, 1, At, B1); PG8_BAR; PG8_SCHED;
            } else {
            PG8_LDB(B0, 0, 0); PG8_SCHED; PG8_LDA(At, 0, 0); PG8_STAGE(PG8_SA(1, 1), a1 + hstep, voffA);
            PG8_WAIT_L(8); PG8_BAR; PG8_WAIT_L(0); PG8_MMA(0, 0, At, B0); PG8_BAR; PG8_SCHED;
            PG8_LDB(B1, 0, 1); PG8_STAGE(PG8_SB(0, 0), b2, voffB);
            PG8_BAR; PG8_WAIT_L(0); PG8_MMA(0, 1, At, B1); PG8_BAR;
            PG8_LDA(At, 0, 1); PG8_STAGE(PG8_SA(0, 0), a2, voffA);
            PG8_BAR; PG8_WAIT_L(0); PG8_MMA(1, 0, At, B0); PG8_BAR; PG8_SCHED;
            PG8_STAGE(PG8_SB(0, 1), b2 + hstep, voffB);
            PG8_WAIT_V(6); PG8_BAR; PG8_MMA(1, 1, At, B1); PG8_BAR;
            PG8_LDB(B0, 1, 0); PG8_SCHED; PG8_LDA(At, 1, 0); PG8_STAGE(PG8_SA(0, 1), a2 + hstep, voffA);
            PG8_WAIT_L(8); PG8_BAR; PG8_WAIT_L(0); PG8_MMA(0, 0, At, B0); PG8_BAR; PG8_SCHED;
            PG8_LDB(B1, 1, 1); PG8_STAGE(PG8_SB(1, 0), b3, voffB);
            PG8_BAR; PG8_WAIT_L(0); PG8_MMA(0, 1, At, B1); PG8_BAR;
            PG8_LDA(At, 1, 1); PG8_STAGE(PG8_SA(1, 0), a3, voffA);
            PG8_BAR; PG8_WAIT_L(0); PG8_MMA(1, 0, At, B0); PG8_BAR; PG8_SCHED;
            PG8_STAGE(PG8_SB(1, 1), b3 + hstep, voffB);
            PG8_WAIT_V(6); PG8_BAR; PG8_MMA(1, 1, At, B1); PG8_BAR;
            }
        }
        if constexpr (ALIGN_EPI) { if (wr == 0) PG8_BAR; }
        if constexpr (!Epi::AFTER_DRAIN) { E(acc, cur, wr, wc, fr, fq); S.done(cur); }
        if (!has_next) break;
#pragma unroll
        for (int a = 0; a < 2; ++a)
#pragma unroll
            for (int b = 0; b < 2; ++b)
#pragma unroll
                for (int m = 0; m < 4; ++m)
#pragma unroll
                    for (int n = 0; n < 2; ++n) acc[a][b][m][n] = (f32x4){0.f, 0.f, 0.f, 0.f};
        cur = nxt; cA = nA; cB = nB; ++ui;
        if constexpr (ALIGN_EPI) { if (wr == 1) PG8_BAR; }
    }
    PG8_WAIT_V(0);
    if constexpr (!ALIGN_EPI) { if (wr == 0) PG8_BAR; }
    PG8_BAR;
    if constexpr (Epi::AFTER_DRAIN) { E.fused(acc, cur, wr, wc, fr, fq, lds, wid, lane); S.done(cur); }
#undef PG8_SA
#undef PG8_SB
#undef PG8_STAGE
#undef PG8_LDA
#undef PG8_LDB
#undef PG8_MMA
#undef PG8_WAIT_V
#undef PG8_WAIT_L
#undef PG8_BAR
#undef PG8_SCHED
}
}
#define GAS __attribute__((address_space(1)))
#define LAS __attribute__((address_space(3)))
typedef unsigned short bf16;
typedef unsigned v4u __attribute__((ext_vector_type(4)));
typedef float f32x4 __attribute__((ext_vector_type(4)));
typedef short bf16x8 __attribute__((ext_vector_type(8)));
typedef GAS unsigned gu32;
typedef GAS unsigned long long gu64;
#define RLX_AGENT __ATOMIC_RELAXED, __HIP_MEMORY_SCOPE_AGENT
#define LDS_WAIT() asm volatile("s_waitcnt lgkmcnt(0)" ::: "memory")
#define VM_WAIT() asm volatile("s_waitcnt vmcnt(0)" ::: "memory")
__device__ __forceinline__ unsigned long long rt() { return __builtin_amdgcn_s_memrealtime(); }
__device__ __forceinline__ unsigned f2bf(float f) { unsigned u = __builtin_bit_cast(unsigned, f); return (u + 0x7fffu + ((u >> 16) & 1u)) >> 16; }
__device__ __forceinline__ unsigned pk2(float lo, float hi) { return f2bf(lo) | (f2bf(hi) << 16); }
#define XB_TMO      128
#define XB_XCNT(j)  (256  + 64 * (j))
#define XB_XSUB(j)  (1280 + 64 * (j))
#define XB_XGEN(j)  (2304 + 64 * (j))
#define XB_TOP      3328
#define XB_TOPGEN   3392
#define XCD_BAR_WORDS 3456
#define XB_SPIN_CAP (1u << 18)

__device__ __forceinline__ unsigned xb_ld(unsigned* p)              { return __hip_atomic_load(p, __ATOMIC_RELAXED, __HIP_MEMORY_SCOPE_AGENT); }
__device__ __forceinline__ unsigned xb_add(unsigned* p, unsigned v) { return __hip_atomic_fetch_add(p, v, __ATOMIC_RELAXED, __HIP_MEMORY_SCOPE_AGENT); }
__device__ __forceinline__ unsigned xb_xcc_id() { return (unsigned)__builtin_amdgcn_s_getreg((3 << 11) | 20) & 0xFu; }
#define XB_SPIN(cond, bar) do { unsigned _sp = 0; while (cond) { __builtin_amdgcn_s_sleep(1); \
    if ((++_sp & 255u) == 0u) { if (xb_ld(&(bar)[XB_TMO])) break; if (_sp > XB_SPIN_CAP) { atomicAdd(&(bar)[XB_TMO], 1u); break; } } } } while (0)

struct XcdBarrier {
    unsigned* bar; unsigned x;
    volatile LAS unsigned* st;
};

__device__ __forceinline__ XcdBarrier xcd_barrier_post(unsigned* bar, volatile LAS unsigned* st) {
    XcdBarrier b; b.bar = bar; b.x = xb_xcc_id(); b.st = st;
    if (threadIdx.x == 0) (void)xb_add(&bar[XB_XCNT(b.x)], 1u);
    return b;
}
__device__ __forceinline__ void xcd_barrier_complete(unsigned* bar, unsigned x, unsigned& nloc, unsigned& nx) {
    const unsigned G = gridDim.x * gridDim.y * gridDim.z;
    unsigned sum, cnt, mine, sp = 0u;
    for (;;) {
        sum = 0u; cnt = 0u; mine = 0u;
#pragma unroll
        for (unsigned j = 0; j < 16; ++j) { const unsigned c = xb_ld(&bar[XB_XCNT(j)]); sum += c; cnt += (c > 0u) ? 1u : 0u; mine = (j == x) ? c : mine; }
        if (sum == G) break;
        __builtin_amdgcn_s_sleep(1);
        if ((++sp & 255u) == 0u) { if (xb_ld(&bar[XB_TMO])) break; if (sp > XB_SPIN_CAP) { atomicAdd(&bar[XB_TMO], 1u); break; } }
    }
    nloc = mine > 0u ? mine : 1u; nx = cnt > 0u ? cnt : 1u;
}

__device__ __forceinline__ void xcd_barrier(const XcdBarrier& b) {
    asm volatile("s_waitcnt vmcnt(0)" ::: "memory");
    __syncthreads();
    if (threadIdx.x == 0) {
        unsigned* bar = b.bar;
        __builtin_amdgcn_s_waitcnt(0);
        unsigned nloc = b.st[0], nx = b.st[1];
        if (nloc == 0u) { xcd_barrier_complete(bar, b.x, nloc, nx); b.st[0] = nloc; b.st[1] = nx; }
        const unsigned old = xb_add(&bar[XB_XSUB(b.x)], 1u);
        const unsigned gen = old / nloc;
        if (old + 1u == (gen + 1u) * nloc) {
            __builtin_amdgcn_fence(__ATOMIC_RELEASE, "agent");
            asm volatile("s_waitcnt vmcnt(0)" ::: "memory");
            const unsigned og = xb_add(&bar[XB_TOP], 1u);
            const unsigned tg = og / nx;
            if (og + 1u == (tg + 1u) * nx) xb_add(&bar[XB_TOPGEN], 1u);
            else XB_SPIN(xb_ld(&bar[XB_TOPGEN]) == tg, bar);
            __builtin_amdgcn_fence(__ATOMIC_ACQUIRE, "agent");
            xb_add(&bar[XB_XGEN(b.x)], 1u);
            asm volatile("s_waitcnt vmcnt(0)" ::: "memory");
        } else {
            XB_SPIN(xb_ld(&bar[XB_XGEN(b.x)]) == gen, bar);
            __builtin_amdgcn_fence(__ATOMIC_ACQUIRE, "agent");
            asm volatile("s_waitcnt vmcnt(0)" ::: "memory");
        }
    }
    __syncthreads();
}
constexpr int NWAVES = 8;
constexpr int D = 2048, T = 8192, CTX = 256, MT = T + CTX, FF = 5632, INC = 8192, HW = 1024, NMOD = 9;
constexpr float EPS = 1e-6f;
constexpr int N_PHASES = 13;
#ifndef MK_N_LAUNCHES
#define MK_N_LAUNCHES 13
#endif

constexpr size_t MiB = 1u << 20;
constexpr size_t WS_CTL = 0, CTL_ZERO_BYTES = 1 * MiB;
constexpr size_t WS_MOD = 256 * 1024;
constexpr size_t WS_TAB = 1 * MiB;
constexpr size_t WS_W1 = 2 * MiB, WS_WD1 = 46 * MiB, WS_WIN = 68 * MiB, WS_WOUT = 100 * MiB, WS_W2 = 108 * MiB, WS_WD2 = 152 * MiB;
constexpr size_t WS_U = 174 * MiB;
constexpr size_t WS_HC = 207 * MiB;
constexpr size_t WS_P = 209 * MiB;
constexpr size_t P_BF = (size_t)MT * HW * 2, P_F32 = (size_t)MT * HW * 4;
constexpr size_t WS_HQ = WS_P, WS_HK0 = WS_HQ + P_BF, WS_HK1 = WS_HK0 + P_BF, WS_HV = WS_HK1 + P_BF, WS_HG = WS_HV + P_BF, WS_NQ = WS_HG + P_BF, WS_NK = WS_NQ + P_BF, WS_NV = WS_NK + P_BF,
                 WS_LF0 = WS_NV + P_BF, WS_LF1 = WS_LF0 + P_F32, WS_PEND = WS_LF1 + P_F32;
constexpr size_t WS_HID = WS_P;
constexpr size_t WS_MX = 408 * MiB;
constexpr size_t WS_END = WS_MX + 2 * (size_t)T * HW * 4;
static_assert(WS_PEND <= WS_MX && WS_HID + (size_t)MT * FF * 2 <= WS_MX && WS_U + (size_t)MT * D * 2 <= WS_HC && WS_WD2 + (size_t)D * FF * 2 <= WS_U, "d_ws map");
constexpr int CW_BAR = 4096;

constexpr int RING_OFF = 0, SCR_BYTES = 139264;
constexpr int MISC_OFF = SCR_BYTES;
constexpr int LDS_BYTES = 147456;

struct Frame {
    LAS unsigned char* lds;
    volatile LAS unsigned* MISC;
    gu32* ctl;
    int tid, lane, wave, vcu, G;
    const float* in[19]; float* out; unsigned char* ws;
};
__device__ __forceinline__ float wave_sum(float v) {
#pragma unroll
    for (int o = 1; o < 64; o <<= 1) v += __shfl_xor(v, o);
    return v;
}
__device__ __forceinline__ float wave_max(float v) {
#pragma unroll
    for (int o = 1; o < 64; o <<= 1) v = fmaxf(v, __shfl_xor(v, o));
    return v;
}
__device__ __forceinline__ float bf2f(unsigned short b) { return __builtin_bit_cast(float, (unsigned)b << 16); }
__device__ __forceinline__ float bflo(unsigned w) { return __builtin_bit_cast(float, w << 16); }
__device__ __forceinline__ float bfhi(unsigned w) { return __builtin_bit_cast(float, w & 0xffff0000u); }
__device__ __forceinline__ float silu_d(float v) { return v / (1.0f + __expf(-v)); }

__device__ __forceinline__ int dst_row(int kind, int n) {
    if (kind == 0) return n;
    if (kind == 1) return 256 * (n >> 7) + (n & 127);
    if (kind == 2) return 256 * (n >> 7) + 128 + (n & 127);
    const int grp = n >> 10;
    if (grp != 5 && grp != 6) return n;
    const int head = (n & 1023) >> 7, dim = n & 127, half = dim >> 6, bj = (dim & 63) >> 5, i = dim & 31;
    return grp * 1024 + 256 * (head >> 1) + 128 * bj + 32 * (2 * (head & 1) + half) + i;
}
__device__ __forceinline__ void conv_item(const float* W, int K, int N, bf16* WT, int kind, LAS float* scr, int item, int lane) {
    const int nblk = N >> 6, kb = item / nblk, nb = item - kb * nblk, k0 = 64 * kb, n0 = 64 * nb;
    const GAS f32x4* src = (const GAS f32x4*)(W + (size_t)(k0 + (lane >> 4)) * N + n0 + 4 * (lane & 15));
#pragma unroll
    for (int i = 0; i < 16; ++i) { const f32x4 v = src[(size_t)i * N]; *(LAS f32x4*)(scr + ((lane >> 4) + 4 * i) * 68 + 4 * (lane & 15)) = v; }
    LDS_WAIT(); asm volatile("" ::: "memory");
    GAS v4u* dst = (GAS v4u*)(WT + (size_t)dst_row(kind, n0 + lane) * K + k0);
#pragma unroll
    for (int c = 0; c < 8; ++c) { const LAS float* s = scr + (8 * c) * 68 + lane;
        v4u o; o.x = pk2(s[0 * 68], s[1 * 68]); o.y = pk2(s[2 * 68], s[3 * 68]); o.z = pk2(s[4 * 68], s[5 * 68]); o.w = pk2(s[6 * 68], s[7 * 68]); dst[c] = o; }
    LDS_WAIT(); asm volatile("" ::: "memory");
}
__device__ __forceinline__ void p0_prologue(Frame& F) {
    LAS float* scr = (LAS float*)(F.lds + RING_OFF + F.wave * 17408);
    const int gw = F.vcu * NWAVES + F.wave, NGW = F.G * NWAVES, lane = F.lane;
    unsigned char* ws = F.ws;
    float* tab = (float*)(ws + WS_TAB);
    for (int i = gw * 64 + lane; i < 4096; i += NGW * 64) { const int pos = i >> 5, fi = i & 31; const float inv = powf(10000.0f, -(float)fi / 32.0f); const float ang = (float)pos * inv; tab[i] = cosf(ang); tab[4096 + i] = sinf(ang); }
    for (int i = gw * 64 + lane; i < 2048; i += NGW * 64) { const int d = i >> 10, c = i & 1023; const float* lg = F.in[11] + d * 2048 + c; const float a = lg[0], b = lg[1024]; tab[16384 + i] = 1.0f / (1.0f + expf(b - a)); }
    {
        const float* wm = F.in[4]; float* mod = (float*)(ws + WS_MOD);
        for (int it = gw; it < 64 * 72; it += NGW) {
            const int kb = it / 72, cb = it - kb * 72, k0 = 32 * kb, col = 256 * cb + 4 * lane;
            const float sl = silu_d(F.in[1][k0 + (lane & 31)]), sc = silu_d(F.in[3][k0 + (lane & 31)]);
            f32x4 al = (f32x4){0.f, 0.f, 0.f, 0.f}, ac = al;
            if (kb == 0) { al = *(const GAS f32x4*)(F.in[5] + col); ac = al; }
            const GAS f32x4* wp = (const GAS f32x4*)(wm + (size_t)k0 * (NMOD * D) + col);
#pragma unroll 8
            for (int kk = 0; kk < 32; ++kk) { const f32x4 w = wp[(size_t)kk * (NMOD * D / 4)]; const float a = __shfl(sl, kk), b = __shfl(sc, kk); al += w * a; ac += w * b; }
#pragma unroll
            for (int e = 0; e < 4; ++e) { atomicAdd(mod + col + e, al[e]); atomicAdd(mod + NMOD * D + col + e, ac[e]); }
        }
    }
    constexpr int I_GU = (D / 64) * (FF / 64), I_DN = (FF / 64) * (D / 64), I_IN = (D / 64) * (INC / 64), I_OUT = (D / 64) * (D / 64);
    constexpr int NITEMS = 6 * I_GU + I_IN + I_OUT;
    static_assert(I_GU == I_DN, "");
    for (int it = gw; it < NITEMS; it += NGW) {
        int r = it;
        if (r < I_GU) { conv_item(F.in[7], D, FF, (bf16*)(ws + WS_W1), 1, scr, r, lane); continue; } r -= I_GU;
        if (r < I_GU) { conv_item(F.in[8], D, FF, (bf16*)(ws + WS_W1), 2, scr, r, lane); continue; } r -= I_GU;
        if (r < I_DN) { conv_item(F.in[9], FF, D, (bf16*)(ws + WS_WD1), 0, scr, r, lane); continue; } r -= I_DN;
        if (r < I_IN) { conv_item(F.in[10], D, INC, (bf16*)(ws + WS_WIN), 3, scr, r, lane); continue; } r -= I_IN;
        if (r < I_OUT) { conv_item(F.in[14], D, D, (bf16*)(ws + WS_WOUT), 0, scr, r, lane); continue; } r -= I_OUT;
        if (r < I_GU) { conv_item(F.in[15], D, FF, (bf16*)(ws + WS_W2), 1, scr, r, lane); continue; } r -= I_GU;
        if (r < I_GU) { conv_item(F.in[16], D, FF, (bf16*)(ws + WS_W2), 2, scr, r, lane); continue; } r -= I_GU;
        conv_item(F.in[17], FF, D, (bf16*)(ws + WS_WD2), 0, scr, r, lane);
    }
}
__device__ __forceinline__ void norm_mod_phase(Frame& F, const float* src_l, const float* src_c, int nrows, int nwj, int shj, int scj) {
    const int gw = F.vcu * NWAVES + F.wave, NGW = F.G * NWAVES;
    const float* mod = (const float*)(F.ws + WS_MOD); bf16* U = (bf16*)(F.ws + WS_U);
    for (int row = gw; row < nrows; row += NGW) {
        const bool isc = row >= T; const float* hr = isc ? src_c + (size_t)(row - T) * D : src_l + (size_t)row * D; const float* mv = mod + (isc ? NMOD * D : 0);
        const GAS f32x4* xr = (const GAS f32x4*)hr + F.lane;
        f32x4 v[8]; float s = 0.f;
#pragma unroll
        for (int j = 0; j < 8; ++j) { v[j] = xr[64 * j]; s += (v[j].x * v[j].x + v[j].y * v[j].y) + (v[j].z * v[j].z + v[j].w * v[j].w); }
        const float rs = 1.0f / sqrtf(wave_sum(s) * (1.0f / D) + EPS);
        GAS unsigned long long* o8 = (GAS unsigned long long*)(U + (size_t)row * D) + F.lane;
#pragma unroll
        for (int j = 0; j < 8; ++j) { const int col = 4 * F.lane + 256 * j;
            const f32x4 nw = *(const GAS f32x4*)(F.in[6] + nwj * D + col), sc = *(const GAS f32x4*)(mv + scj * D + col), sh = *(const GAS f32x4*)(mv + shj * D + col);
            const f32x4 o = v[j] * rs * nw * (sc + 1.0f) + sh;
            o8[64 * j] = (unsigned long long)pk2(o.x, o.y) | ((unsigned long long)pk2(o.z, o.w) << 32); }
    }
}
__device__ __forceinline__ void final_norm_phase(Frame& F) {
    const int gw = F.vcu * NWAVES + F.wave, NGW = F.G * NWAVES;
    for (int row = gw; row < T; row += NGW) {
        GAS f32x4* xr = (GAS f32x4*)(F.out + (size_t)row * D) + F.lane;
        f32x4 v[8]; float s = 0.f;
#pragma unroll
        for (int j = 0; j < 8; ++j) { v[j] = xr[64 * j]; s += (v[j].x * v[j].x + v[j].y * v[j].y) + (v[j].z * v[j].z + v[j].w * v[j].w); }
        const float rs = 1.0f / sqrtf(wave_sum(s) * (1.0f / D) + EPS);
#pragma unroll
        for (int j = 0; j < 8; ++j) { const f32x4 fw = *(const GAS f32x4*)(F.in[18] + 4 * F.lane + 256 * j); xr[64 * j] = v[j] * rs * fw; }
    }
}
__device__ __forceinline__ void hgrn_simple(Frame& F) {
    if (F.wave != 0 || F.vcu >= 32) return;
    const int item = F.vcu, h = item >> 2, dir = (item >> 1) & 1, vh = item & 1, lane = F.lane;
    unsigned char* ws = F.ws;
    const bf16* HQ = (const bf16*)(ws + WS_HQ); const bf16* HK = (const bf16*)(ws + (dir ? WS_HK1 : WS_HK0)); const float* LF = (const float*)(ws + (dir ? WS_LF1 : WS_LF0)); const bf16* HV = (const bf16*)(ws + WS_HV);
    float* OF = (float*)(ws + WS_MX) + (size_t)dir * T * HW;
    LAS float* buf = (LAS float*)(F.lds + RING_OFF);
    LAS float* vbuf = buf + 8 * 3 * 128;
    float S[128];
#pragma unroll
    for (int d = 0; d < 128; ++d) S[d] = 0.f;
    for (int b = 0; b < MT / 8; ++b) {
#pragma unroll
        for (int j = 0; j < 8; ++j) {
            const int tau = 8 * b + j; const int row = tau < CTX ? T + (dir ? CTX - 1 - tau : tau) : (dir ? T - 1 - (tau - CTX) : tau - CTX);
            const size_t o = (size_t)row * HW + h * 128;
            const unsigned q2 = *(const GAS unsigned*)(HQ + o + 2 * lane), k2 = *(const GAS unsigned*)(HK + o + 2 * lane); const float lf0 = LF[o + 2 * lane], lf1 = LF[o + 2 * lane + 1];
            const float vv = bf2f(HV[o + vh * 64 + lane]);
            buf[j * 384 + 2 * lane] = bflo(q2); buf[j * 384 + 2 * lane + 1] = bfhi(q2);
            buf[j * 384 + 128 + 2 * lane] = bflo(k2); buf[j * 384 + 128 + 2 * lane + 1] = bfhi(k2);
            buf[j * 384 + 256 + 2 * lane] = __expf(lf0); buf[j * 384 + 256 + 2 * lane + 1] = __expf(lf1);
            vbuf[j * 64 + lane] = vv;
        }
        LDS_WAIT(); asm volatile("" ::: "memory");
#pragma unroll 1
        for (int j = 0; j < 8; ++j) {
            const float vv = vbuf[j * 64 + lane]; float o = 0.f;
#pragma unroll
            for (int d4 = 0; d4 < 32; ++d4) {
                const f32x4 q = *(const LAS f32x4*)(buf + j * 384 + 4 * d4), k = *(const LAS f32x4*)(buf + j * 384 + 128 + 4 * d4), f = *(const LAS f32x4*)(buf + j * 384 + 256 + 4 * d4);
#pragma unroll
                for (int e = 0; e < 4; ++e) { S[4 * d4 + e] = f[e] * S[4 * d4 + e] + k[e] * vv; o += q[e] * S[4 * d4 + e]; }
            }
            const int tau = 8 * b + j;
            if (tau >= CTX) { const int row = dir ? T - 1 - (tau - CTX) : tau - CTX; OF[(size_t)row * HW + h * 128 + vh * 64 + lane] = o; }
        }
        LDS_WAIT(); asm volatile("" ::: "memory");
    }
}
__device__ __forceinline__ void na_simple(Frame& F) {
    const int lane = F.lane; unsigned char* ws = F.ws;
    const bf16* NQ = (const bf16*)(ws + WS_NQ); const bf16* NK = (const bf16*)(ws + WS_NK); const bf16* NV = (const bf16*)(ws + WS_NV); bf16* MIX = (bf16*)(ws + WS_U);
    const float* rpb = F.in[13];
    LAS float* qs = (LAS float*)(F.lds + RING_OFF + 16384 + F.wave * 4096);
    LAS float* ps = qs + 128;
    int nw = 0, myw = -1;
    { const int gw = F.vcu * NWAVES + F.wave; if (F.vcu < 32) { if (F.wave != 0) myw = F.vcu * 7 + F.wave - 1; } else myw = 32 * 7 + (F.vcu - 32) * 8 + F.wave; nw = 32 * 7 + (F.G - 32) * 8; (void)gw; }
    if (myw < 0) return;
    for (int it = myw; it < T * 8; it += nw) {
        const int t = it >> 3, h = it & 7, r = t >> 6, cq = t & 63;
        const int rs = min(max(r - 4, 0), 120), cs = min(max(cq - 8, 0), 48);
        { const unsigned q2 = *(const GAS unsigned*)(NQ + (size_t)t * HW + h * 128 + 2 * lane); qs[2 * lane] = bflo(q2); qs[2 * lane + 1] = bfhi(q2); }
        LDS_WAIT(); asm volatile("" ::: "memory");
        float s[6];
#pragma unroll
        for (int kk = 0; kk < 6; ++kk) {
            const int key = lane + 64 * kk; int tok; float bias = 0.f;
            if (kk < 2) { const int kr = key >> 4, kc = key & 15; tok = (rs + kr) * 64 + cs + kc; bias = rpb[h * 465 + (rs + kr - r + 7) * 31 + (cs + kc - cq + 15)]; }
            else tok = T + key - 128;
            const GAS v4u* kp = (const GAS v4u*)(NK + (size_t)tok * HW + h * 128);
            float a = 0.f;
#pragma unroll
            for (int c = 0; c < 16; ++c) { const v4u w = kp[c]; const f32x4 q0 = *(const LAS f32x4*)(qs + 8 * c), q1 = *(const LAS f32x4*)(qs + 8 * c + 4);
                a += bflo(w.x) * q0[0] + bfhi(w.x) * q0[1] + bflo(w.y) * q0[2] + bfhi(w.y) * q0[3] + bflo(w.z) * q1[0] + bfhi(w.z) * q1[1] + bflo(w.w) * q1[2] + bfhi(w.w) * q1[3]; }
            s[kk] = a + bias;
        }
        float mx = s[0];
#pragma unroll
        for (int kk = 1; kk < 6; ++kk) mx = fmaxf(mx, s[kk]);
        mx = wave_max(mx);
        float sum = 0.f;
#pragma unroll
        for (int kk = 0; kk < 6; ++kk) { const float p = __expf(s[kk] - mx); sum += p; ps[lane + 64 * kk] = p; }
        sum = wave_sum(sum);
        LDS_WAIT(); asm volatile("" ::: "memory");
        float o0 = 0.f, o1 = 0.f;
        for (int kr = 0; kr < 8; ++kr)
#pragma unroll 4
            for (int kc = 0; kc < 16; ++kc) { const int tok = (rs + kr) * 64 + cs + kc; const float p = ps[kr * 16 + kc]; const unsigned v2 = *(const GAS unsigned*)(NV + (size_t)tok * HW + h * 128 + 2 * lane); o0 += p * bflo(v2); o1 += p * bfhi(v2); }
#pragma unroll 4
        for (int j = 0; j < CTX; ++j) { const float p = ps[128 + j]; const unsigned v2 = *(const GAS unsigned*)(NV + (size_t)(T + j) * HW + h * 128 + 2 * lane); o0 += p * bflo(v2); o1 += p * bfhi(v2); }
        const float inv = 1.0f / sum;
        *(GAS unsigned*)(MIX + (size_t)t * D + HW + h * 128 + 2 * lane) = pk2(o0 * inv, o1 * inv);
        LDS_WAIT(); asm volatile("" ::: "memory");
    }
}
__device__ __forceinline__ void readout_simple(Frame& F) {
    const int gw = F.vcu * NWAVES + F.wave, NGW = F.G * NWAVES, lane = F.lane; unsigned char* ws = F.ws;
    const float* OF = (const float*)(ws + WS_MX); const bf16* HG = (const bf16*)(ws + WS_HG); bf16* MIX = (bf16*)(ws + WS_U);
    for (int t = gw; t < T; t += NGW) {
        const size_t o = (size_t)t * HW + 16 * lane; float v[16]; float ss = 0.f;
#pragma unroll
        for (int j = 0; j < 4; ++j) { const f32x4 a = *(const GAS f32x4*)(OF + o + 4 * j), b = *(const GAS f32x4*)(OF + (size_t)T * HW + o + 4 * j);
#pragma unroll
            for (int e = 0; e < 4; ++e) { v[4 * j + e] = a[e] + b[e]; ss += v[4 * j + e] * v[4 * j + e]; } }
        ss += __shfl_xor(ss, 1); ss += __shfl_xor(ss, 2); ss += __shfl_xor(ss, 4);
        const float rs = 1.0f / sqrtf(ss * (1.0f / 128.0f) + EPS);
        const v4u g0 = *(const GAS v4u*)(HG + o), g1 = *(const GAS v4u*)(HG + o + 8);
        const unsigned gw_[8] = {g0.x, g0.y, g0.z, g0.w, g1.x, g1.y, g1.z, g1.w};
        const float* nw = F.in[12] + (16 * lane & 127);
        unsigned ow[8];
#pragma unroll
        for (int j = 0; j < 8; ++j) ow[j] = pk2(v[2 * j] * rs * nw[2 * j] * bflo(gw_[j]), v[2 * j + 1] * rs * nw[2 * j + 1] * bfhi(gw_[j]));
        GAS v4u* mp = (GAS v4u*)(MIX + (size_t)t * D + 16 * lane);
        mp[0] = (v4u){ow[0], ow[1], ow[2], ow[3]}; mp[1] = (v4u){ow[4], ow[5], ow[6], ow[7]};
    }
}

struct Args { const float* in[19]; float* out; unsigned char* ws; int ph_lo, ph_hi; };
__global__ void __launch_bounds__(NWAVES * 64, 2) mk_fwd(Args args) {
    extern __shared__ __attribute__((aligned(16))) unsigned char lds[];
    Frame F;
    F.lds = (LAS unsigned char*)lds;
    F.MISC = (volatile LAS unsigned*)(F.lds + MISC_OFF);
    F.tid = threadIdx.x; F.lane = F.tid & 63; F.wave = __builtin_amdgcn_readfirstlane(F.tid >> 6);
    F.G = gridDim.x; { const int bx = blockIdx.x; F.vcu = (F.G % 8 == 0) ? (bx % 8) * (F.G / 8) + bx / 8 : bx; }
    unsigned char* ws = args.ws; F.ws = ws; F.out = args.out;
#pragma unroll
    for (int i = 0; i < 19; ++i) F.in[i] = args.in[i];
    F.ctl = (gu32*)(ws + WS_CTL);
    for (int u = F.tid; u < 32; u += NWAVES * 64) ((LAS unsigned*)(F.lds + MISC_OFF))[u] = 0u;
    __syncthreads();
    const int lo = args.ph_lo, hi = args.ph_hi;
    XcdBarrier bar; bar.bar = (unsigned*)(F.ctl + CW_BAR); bar.x = 0; bar.st = nullptr;
    if (hi - lo > 1) bar = xcd_barrier_post((unsigned*)(F.ctl + CW_BAR), F.MISC + 8);
#define IN(k) (lo <= (k) && (k) < hi)
#define SEAM(k) do { if (IN(k) && IN((k) + 1)) xcd_barrier(bar); } while (0)
    const float* mod = (const float*)(ws + WS_MOD);
    bf16* U = (bf16*)(ws + WS_U); bf16* HID = (bf16*)(ws + WS_HID); float* HC = (float*)(ws + WS_HC);

    if (IN(0)) { p0_prologue(F); } SEAM(0);
    if (IN(1)) { norm_mod_phase(F, F.in[0], F.in[2], MT, 0, 0, 1); } SEAM(1);
    if (IN(2)) {
        pg8::Gemm g{U, (const bf16*)(ws + WS_W1), MT, 2 * FF, D}; pg8::StaticOrder S; S.init(MT, 2 * FF, F.G, (int)blockIdx.x);
        pg8::EpiSwiglu E{HID, FF};
        pg8::gemm_phase<pg8::EpiSwiglu, pg8::StaticOrder, true, true>(F.lds + RING_OFF, g, S, E);
    } SEAM(2);
    if (IN(3)) {
        pg8::Gemm g{HID, (const bf16*)(ws + WS_WD1), MT, D, FF}; pg8::StaticOrder S; S.init(MT, D, F.G, (int)blockIdx.x);
        pg8::EpiResid E{F.in[0], F.in[2], F.out, HC, mod + 2 * D, mod + NMOD * D + 2 * D, 0.5f};
        pg8::gemm_phase<pg8::EpiResid, pg8::StaticOrder, true, true>(F.lds + RING_OFF, g, S, E);
    } SEAM(3);
    if (IN(4)) { norm_mod_phase(F, F.out, HC, MT, 1, 3, 4); } SEAM(4);
    if (IN(5)) {
        pg8::Gemm g{U, (const bf16*)(ws + WS_WIN), MT, INC, D}; pg8::StaticOrder S; S.init(MT, INC, F.G, (int)blockIdx.x);
        pg8::EpiWin E{(bf16*)(ws + WS_HQ), (bf16*)(ws + WS_HK0), (bf16*)(ws + WS_HK1), (float*)(ws + WS_LF0), (float*)(ws + WS_LF1), (bf16*)(ws + WS_HV), (bf16*)(ws + WS_HG),
                      (bf16*)(ws + WS_NQ), (bf16*)(ws + WS_NK), (bf16*)(ws + WS_NV), (const float*)(ws + WS_TAB) + 16384, (const float*)(ws + WS_TAB)};
        pg8::gemm_phase<pg8::EpiWin, pg8::StaticOrder, true, true>(F.lds + RING_OFF, g, S, E);
    } SEAM(5);
    if (IN(6)) { hgrn_simple(F); na_simple(F); } SEAM(6);
    if (IN(7)) { readout_simple(F); } SEAM(7);
    if (IN(8)) {
        pg8::Gemm g{U, (const bf16*)(ws + WS_WOUT), T, D, D}; pg8::StaticOrder S; S.init(T, D, F.G, (int)blockIdx.x);
        pg8::EpiResid E{F.out, F.out, F.out, F.out, mod + 5 * D, mod + 5 * D, 1.0f};
        pg8::gemm_phase<pg8::EpiResid, pg8::StaticOrder, true, true>(F.lds + RING_OFF, g, S, E);
    } SEAM(8);
    if (IN(9)) { norm_mod_phase(F, F.out, F.out, T, 2, 6, 7); } SEAM(9);
    if (IN(10)) {
        pg8::Gemm g{U, (const bf16*)(ws + WS_W2), T, 2 * FF, D}; pg8::StaticOrder S; S.init(T, 2 * FF, F.G, (int)blockIdx.x);
        pg8::EpiSwiglu E{HID, FF};
        pg8::gemm_phase<pg8::EpiSwiglu, pg8::StaticOrder, true, true>(F.lds + RING_OFF, g, S, E);
    } SEAM(10);
    if (IN(11)) {
        pg8::Gemm g{HID, (const bf16*)(ws + WS_WD2), T, D, FF}; pg8::StaticOrder S; S.init(T, D, F.G, (int)blockIdx.x);
        pg8::EpiResid E{F.out, F.out, F.out, F.out, mod + 8 * D, mod + 8 * D, 0.5f};
        pg8::gemm_phase<pg8::EpiResid, pg8::StaticOrder, true, true>(F.lds + RING_OFF, g, S, E);
    } SEAM(11);
    if (IN(12)) { final_norm_phase(F); }
#undef IN
#undef SEAM
}

extern "C" void kernel_launch(void* const* d_in, const int* in_sizes, int n_in, void* d_out, int out_size, void* d_ws, size_t ws_size, hipStream_t stream) {
    static int grid = 0;
    if (grid == 0) {
        if (n_in != 19 || out_size != T * D || ws_size < WS_END) { fprintf(stderr, "kernel_launch: unexpected shapes: n_in %d out %d ws %zu (need %zu)\n", n_in, out_size, ws_size, (size_t)WS_END); grid = -1; return; }
        int dev = 0, cus = 0, per_cu = 0;
        if (hipGetDevice(&dev) != hipSuccess || hipDeviceGetAttribute(&cus, hipDeviceAttributeMultiprocessorCount, dev) != hipSuccess) { grid = -1; return; }
        if (hipFuncSetAttribute((const void*)mk_fwd, hipFuncAttributeMaxDynamicSharedMemorySize, LDS_BYTES) != hipSuccess) { fprintf(stderr, "kernel_launch: hipFuncSetAttribute failed\n"); grid = -1; return; }
        if (hipOccupancyMaxActiveBlocksPerMultiprocessor(&per_cu, (const void*)mk_fwd, NWAVES * 64, LDS_BYTES) != hipSuccess || per_cu < 1) { fprintf(stderr, "kernel_launch: occupancy query says %d\n", per_cu); per_cu = 1; }
        (void)hipGetLastError();
        grid = cus;
    }
    if (grid < 0) return;
    (void)hipMemsetAsync((char*)d_ws + WS_CTL, 0, CTL_ZERO_BYTES, stream);
    Args a{};
    for (int i = 0; i < 19; ++i) a.in[i] = (const float*)d_in[i];
    a.out = (float*)d_out; a.ws = (unsigned char*)d_ws;
    constexpr int NL = MK_N_LAUNCHES;
    for (int li = 0; li < NL; ++li) {
        a.ph_lo = (NL == 1) ? 0 : li; a.ph_hi = (NL == 1) ? N_PHASES : li + 1;
        if (NL == 1) { void* kargs[] = {&a}; hipError_t e = hipLaunchCooperativeKernel((const void*)mk_fwd, dim3(grid), dim3(NWAVES * 64), kargs, LDS_BYTES, stream);
            if (e != hipSuccess) fprintf(stderr, "cooperative launch failed: %s (grid %d)\n", hipGetErrorString(e), grid); }
        else hipLaunchKernelGGL(mk_fwd, dim3(grid), dim3(NWAVES * 64), LDS_BYTES, stream, a);
    }
}
```

```cpp
#include <hip/hip_runtime.h>
#include <cstdio>
#include <cstdint>
#include <cmath>
namespace pg8 {
#define PG8_LAS __attribute__((address_space(3)))
typedef unsigned short bf16_t;
typedef short bf16x8 __attribute__((ext_vector_type(8)));
typedef float f32x4 __attribute__((ext_vector_type(4)));
typedef unsigned u32x4 __attribute__((ext_vector_type(4)));
constexpr int BM = 256, BK = 64, HALF = 128, HTB = HALF * BK * 2  , STAGE_BYTES = 8 * HTB, NXCD = 8, WGM = 8;

__host__ __device__ __forceinline__ int lds_byte(int r, int c) { const int st = (r >> 4) * 2 + (c >> 5), rr = r & 15, cc = c & 31, ob = rr * 64 + cc * 2; return st * 1024 + (ob ^ (((ob >> 9) & 1) << 5)); }
__host__ __device__ __forceinline__ void stage_rc(int b, int& R, int& C) { const int st = b / 1024, sb = b % 1024, swz = sb ^ (((sb >> 9) & 1) << 5); R = (st >> 1) * 16 + swz / 64; C = (st & 1) * 32 + (swz % 64) / 2; }
__host__ __device__ __forceinline__ int perm32(int rho) { const int n = rho >> 4, i = rho & 15; return 8 * (i >> 2) + 4 * n + (i & 3); }

struct Unit { int pm, pn; };
struct Gemm { const bf16_t* A; const bf16_t* Bt; int M, N, K; };

struct StaticOrder {
    int nM, nN, nwg, G, c;
    __host__ __device__ void init(int M, int N, int G_, int c_) { nM = M / BM; nN = N / BM; nwg = nM * nN; G = G_; c = c_; }
    __host__ __device__ bool next(int i, Unit& u) const {
        const long L = (long)i * G + c; if (L >= nwg) return false;
        int wgid = (int)L; { const int q = nwg / NXCD, r = nwg % NXCD, xcd = wgid % NXCD, off = wgid / NXCD; wgid = (xcd < r ? xcd * (q + 1) : r * (q + 1) + (xcd - r) * q) + off; }
        const int nig = WGM * nN, gid = wgid / nig, fm = gid * WGM, gsz = (nM - fm) < WGM ? (nM - fm) : WGM;
        u.pm = fm + ((wgid % nig) % gsz); u.pn = (wgid % nig) / gsz; return true;
    }
    __device__ __forceinline__ void a_ready(const Unit&) const {}
    __device__ __forceinline__ void done(const Unit&) const {}
};

__device__ __forceinline__ unsigned cvt_pk_bf16(float lo, float hi) { unsigned r; asm volatile("v_cvt_pk_bf16_f32 %0, %1, %2" : "=v"(r) : "v"(lo), "v"(hi)); return r; }
typedef float f32x2 __attribute__((ext_vector_type(2)));
__device__ __forceinline__ float sigmoid_f(float v) { return __builtin_amdgcn_rcpf(1.0f + __builtin_amdgcn_exp2f(-1.44269504089f * v)); }
__device__ __forceinline__ float silu_f(float v) { return v * sigmoid_f(v); }

struct EpiSwiglu {
    static constexpr bool PERM = true, AFTER_DRAIN = false;
    bf16_t* H; int ldh;
    __device__ __forceinline__ void operator()(const f32x4 (&acc)[2][2][4][2], const Unit& u, int wr, int wc, int fr, int fq) const {
        const int row0 = u.pm * BM + wr * 64 + fr, col0 = u.pn * HALF + wc * 32 + 8 * fq;
#pragma unroll
        for (int ai = 0; ai < 2; ++ai)
#pragma unroll
            for (int m = 0; m < 4; ++m) { bf16_t* rowp = H + (size_t)(row0 + ai * HALF + m * 16) * ldh + col0;
                const f32x4 g0 = acc[ai][0][m][0], g1 = acc[ai][0][m][1], u0 = acc[ai][1][m][0], u1 = acc[ai][1][m][1];
                u32x4 w; w.x = cvt_pk_bf16(silu_f(g0[0]) * u0[0], silu_f(g0[1]) * u0[1]); w.y = cvt_pk_bf16(silu_f(g0[2]) * u0[2], silu_f(g0[3]) * u0[3]);
                w.z = cvt_pk_bf16(silu_f(g1[0]) * u1[0], silu_f(g1[1]) * u1[1]); w.w = cvt_pk_bf16(silu_f(g1[2]) * u1[2], silu_f(g1[3]) * u1[3]);
                *(u32x4*)rowp = w; }
    }
};

struct EpiResid {
    static constexpr bool PERM = false, AFTER_DRAIN = false;
    const float* base_l; const float* base_c; float* out_l; float* out_c; const float* gate_l; const float* gate_c; float coef;
    __device__ __forceinline__ void operator()(const f32x4 (&acc)[2][2][4][2], const Unit& u, int wr, int wc, int fr, int fq) const {
        const bool isc = u.pm >= 32;
        const float* base = isc ? base_c : base_l; float* out = isc ? out_c : out_l; const float* gate = isc ? gate_c : gate_l;
        const int row0 = (isc ? 0 : u.pm * BM) + wr * 64 + fr, col0 = u.pn * BM + wc * 32 + 4 * fq;
        f32x4 gv[2][2];
#pragma unroll
        for (int bj = 0; bj < 2; ++bj)
#pragma unroll
            for (int n = 0; n < 2; ++n) gv[bj][n] = *(const f32x4*)(gate + col0 + bj * HALF + n * 16) * coef;
#pragma unroll
        for (int ai = 0; ai < 2; ++ai)
#pragma unroll
            for (int m = 0; m < 4; ++m) { const size_t off = (size_t)(row0 + ai * HALF + m * 16) * 2048 + col0;
#pragma unroll
                for (int bj = 0; bj < 2; ++bj)
#pragma unroll
                    for (int n = 0; n < 2; ++n) { const f32x4 b = *(const f32x4*)(base + off + bj * HALF + n * 16); *(f32x4*)(out + off + bj * HALF + n * 16) = b + gv[bj][n] * acc[ai][bj][m][n]; } }
    }
};

struct EpiWin {
    static constexpr bool PERM = true, AFTER_DRAIN = false;
    bf16_t* HQ; bf16_t* HK0; bf16_t* HK1; float* LF0; float* LF1; bf16_t* HV; bf16_t* HG; bf16_t* NQ; bf16_t* NK; bf16_t* NV;
    const float* lb;
    const float* ropeT;
    __device__ __forceinline__ void st8(bf16_t* p, const f32x4 a, const f32x4 b) const { u32x4 w; w.x = cvt_pk_bf16(a[0], a[1]); w.y = cvt_pk_bf16(a[2], a[3]); w.z = cvt_pk_bf16(b[0], b[1]); w.w = cvt_pk_bf16(b[2], b[3]); *(u32x4*)p = w; }
    __device__ __forceinline__ void operator()(const f32x4 (&acc)[2][2][4][2], const Unit& u, int wr, int wc, int fr, int fq) const {
        const int grp = u.pn >> 2, row0 = u.pm * BM + wr * 64 + fr, gc0 = (u.pn & 3) * BM + wc * 32 + 8 * fq;
        if (grp == 0 || grp == 3 || grp == 4 || grp == 7) {
            bf16_t* O = grp == 0 ? HQ : (grp == 3 ? HV : (grp == 4 ? HG : NV)); const bool act = (grp == 0 || grp == 4);
#pragma unroll
            for (int ai = 0; ai < 2; ++ai)
#pragma unroll
                for (int m = 0; m < 4; ++m)
#pragma unroll
                    for (int bj = 0; bj < 2; ++bj) { f32x4 a = acc[ai][bj][m][0], b = acc[ai][bj][m][1];
                        if (act) { a = (f32x4){silu_f(a[0]), silu_f(a[1]), silu_f(a[2]), silu_f(a[3])}; b = (f32x4){silu_f(b[0]), silu_f(b[1]), silu_f(b[2]), silu_f(b[3])}; }
                        st8(O + (size_t)(row0 + ai * HALF + m * 16) * 1024 + gc0 + bj * HALF, a, b); }
        } else if (grp == 1 || grp == 2) {
            const int d = grp - 1; bf16_t* K = d ? HK1 : HK0; float* L = d ? LF1 : LF0;
#pragma unroll
            for (int bj = 0; bj < 2; ++bj) { const f32x4 l0 = *(const f32x4*)(lb + d * 1024 + gc0 + bj * HALF), l1 = *(const f32x4*)(lb + d * 1024 + gc0 + bj * HALF + 4);
#pragma unroll
                for (int ai = 0; ai < 2; ++ai)
#pragma unroll
                    for (int m = 0; m < 4; ++m) { const f32x4 a = acc[ai][bj][m][0], b = acc[ai][bj][m][1]; f32x4 ka, kb, la, lc;
#pragma unroll
                        for (int e = 0; e < 4; ++e) { const float sa = sigmoid_f(a[e]), sb = sigmoid_f(b[e]);
                            ka[e] = (1.0f - l0[e]) * (1.0f - sa); kb[e] = (1.0f - l1[e]) * (1.0f - sb);
                            la[e] = __logf(l0[e] + (1.0f - l0[e]) * sa); lc[e] = __logf(l1[e] + (1.0f - l1[e]) * sb); }
                        const size_t off = (size_t)(row0 + ai * HALF + m * 16) * 1024 + gc0 + bj * HALF;
                        st8(K + off, ka, kb); *(f32x4*)(L + off) = la; *(f32x4*)(L + off + 4) = lc; } }
        } else {
            bf16_t* O = grp == 5 ? NQ : NK; const float sc = grp == 5 ? 0.08838834764831845f : 1.0f;
            const int head = 2 * (u.pn & 3) + (wc >> 1), half = wc & 1, dcol = head * 128 + 64 * half + 8 * fq; const bool isc = u.pm >= 32;
#pragma unroll
            for (int ai = 0; ai < 2; ++ai)
#pragma unroll
                for (int m = 0; m < 4; ++m) { const int row = row0 + ai * HALF + m * 16; const int pos = half ? (row & 63) : ((row >> 6) & 127);
                    f32x4 c0 = (f32x4){1.f, 1.f, 1.f, 1.f}, c1 = c0, s0 = (f32x4){0.f, 0.f, 0.f, 0.f}, s1 = s0;
                    if (!isc) { const float* ct = ropeT + pos * 32 + 8 * fq; c0 = *(const f32x4*)ct; c1 = *(const f32x4*)(ct + 4); s0 = *(const f32x4*)(ct + 4096); s1 = *(const f32x4*)(ct + 4100); }
                    const f32x4 a0 = acc[ai][0][m][0], a1 = acc[ai][0][m][1], b0 = acc[ai][1][m][0], b1 = acc[ai][1][m][1];
                    bf16_t* p = O + (size_t)row * 1024 + dcol;
                    st8(p, (a0 * c0 - b0 * s0) * sc, (a1 * c1 - b1 * s1) * sc); st8(p + 32, (b0 * c0 + a0 * s0) * sc, (b1 * c1 + a1 * s1) * sc); }
        }
    }
};

template <class Epi, class Sched, bool ALIGN_EPI = false, bool SP2 = false>
__device__ __forceinline__ void gemm_phase(PG8_LAS unsigned char* lds, const Gemm g, const Sched& S, const Epi& E) {
    const int tid = threadIdx.x, wid = __builtin_amdgcn_readfirstlane(tid >> 6), lane = tid & 63, wr = wid >> 2, wc = wid & 3, fr = lane & 15, fq = lane >> 4;
    const int K = g.K, nt = K / BK;
    unsigned voffA[2], voffB[2];
#pragma unroll
    for (int i = 0; i < 2; ++i) { int R, C; stage_rc(tid * 16 + i * 8192, R, C); const int Rb = Epi::PERM ? ((R & ~31) + perm32(R & 31)) : R;
        voffA[i] = (unsigned)(R * K + C) * 2u; voffB[i] = (unsigned)(Rb * K + C) * 2u; }
    const size_t kstep = (size_t)(BK * 2);
    const size_t hstep = (size_t)HALF * K * 2;
    const size_t tstep = 2 * hstep;
    const unsigned ldsw = (unsigned)wid * 1024u;
    const int aoff = lds_byte(wr * 64 + fr, fq * 8), boff = lds_byte(wc * 32 + fr, fq * 8);
#define PG8_SA(b, h) (((b) * 2 + (h)) * HTB)
#define PG8_SB(b, h) ((4 + (b) * 2 + (h)) * HTB)
#define PG8_STAGE(bufoff, gbase, voff) do { _Pragma("unroll") for (int _i = 0; _i < 2; ++_i) \
        __builtin_amdgcn_global_load_lds((const unsigned*)((const char*)(gbase) + (voff)[_i]), (PG8_LAS unsigned*)(lds + (bufoff) + ldsw + _i * 8192), 16, 0, 0); } while (0)
#define PG8_LDA(dst, b, h) do { _Pragma("unroll") for (int m = 0; m < 4; ++m) _Pragma("unroll") for (int k = 0; k < 2; ++k) dst[m][k] = *(const PG8_LAS bf16x8*)(lds + PG8_SA(b, h) + aoff + m * 2048 + k * 1024); } while (0)
#define PG8_LDB(dst, b, h) do { _Pragma("unroll") for (int n = 0; n < 2; ++n) _Pragma("unroll") for (int k = 0; k < 2; ++k) dst[n][k] = *(const PG8_LAS bf16x8*)(lds + PG8_SB(b, h) + boff + n * 2048 + k * 1024); } while (0)
#define PG8_MMA(ai, bj, At, Bt) do { __builtin_amdgcn_s_setprio(1); _Pragma("unroll") for (int m = 0; m < 4; ++m) _Pragma("unroll") for (int n = 0; n < 2; ++n) _Pragma("unroll") for (int k = 0; k < 2; ++k) \
        acc[ai][bj][m][n] = __builtin_amdgcn_mfma_f32_16x16x32_bf16(Bt[n][k], At[m][k], acc[ai][bj][m][n], 0, 0, 0); __builtin_amdgcn_s_setprio(0); } while (0)
#define PG8_WAIT_V(n) asm volatile("s_waitcnt vmcnt(" #n ")" ::: "memory")
#define PG8_WAIT_L(n) asm volatile("s_waitcnt lgkmcnt(" #n ")" ::: "memory")
#define PG8_BAR __builtin_amdgcn_s_barrier()
#define PG8_SCHED __builtin_amdgcn_sched_barrier(0)
    Unit cur, nxt; int ui = 0;
    if (!S.next(0, cur)) return;
    f32x4 acc[2][2][4][2];
#pragma unroll
    for (int a = 0; a < 2; ++a)
#pragma unroll
        for (int b = 0; b < 2; ++b)
#pragma unroll
            for (int m = 0; m < 4; ++m)
#pragma unroll
                for (int n = 0; n < 2; ++n) acc[a][b][m][n] = (f32x4){0.f, 0.f, 0.f, 0.f};
    bf16x8 At[4][2], B0[2][2], B1[2][2];
    const char* cA = (const char*)g.A + (size_t)cur.pm * tstep; const char* cB = (const char*)g.Bt + (size_t)cur.pn * tstep;
    S.a_ready(cur);
    if constexpr (SP2) {
        PG8_STAGE(PG8_SB(0, 0), cB, voffB); PG8_STAGE(PG8_SB(0, 1), cB + hstep, voffB); PG8_STAGE(PG8_SA(0, 0), cA, voffA); PG8_STAGE(PG8_SA(0, 1), cA + hstep, voffA);
        if (wr == 1) PG8_BAR;
        PG8_WAIT_V(2); PG8_BAR;
        PG8_STAGE(PG8_SB(1, 0), cB + kstep, voffB); PG8_STAGE(PG8_SA(1, 0), cA + kstep, voffA); PG8_STAGE(PG8_SB(1, 1), cB + hstep + kstep, voffB);
        PG8_WAIT_V(6); PG8_BAR;
    } else {
        PG8_STAGE(PG8_SB(0, 0), cB, voffB); PG8_STAGE(PG8_SA(0, 0), cA, voffA); PG8_STAGE(PG8_SB(0, 1), cB + hstep, voffB); PG8_STAGE(PG8_SA(0, 1), cA + hstep, voffA);
        if (wr == 1) PG8_BAR;
        PG8_WAIT_V(4); PG8_BAR;
        PG8_STAGE(PG8_SB(1, 0), cB + kstep, voffB); PG8_STAGE(PG8_SA(1, 0), cA + kstep, voffA); PG8_STAGE(PG8_SB(1, 1), cB + hstep + kstep, voffB);
        PG8_WAIT_V(6); PG8_BAR;
    }
    for (;;) {
        const bool has_next = S.next(ui + 1, nxt);
        const char* nA = has_next ? (const char*)g.A + (size_t)nxt.pm * tstep : cA; const char* nB = has_next ? (const char*)g.Bt + (size_t)nxt.pn * tstep : cB;
        for (int t = 0; t < nt; t += 2) {
            const bool last = (t == nt - 2);
            const char* a1 = cA + (size_t)(t + 1) * kstep;
            const char* a2 = last ? nA : cA + (size_t)(t + 2) * kstep; const char* b2 = last ? nB : cB + (size_t)(t + 2) * kstep;
            const char* a3 = a2 + kstep; const char* b3 = b2 + kstep;
            if (last && has_next) S.a_ready(nxt);
            if constexpr (SP2) {
            PG8_LDB(B0, 0, 0); PG8_LDB(B1, 0, 1); PG8_SCHED; PG8_LDA(At, 0, 0); PG8_STAGE(PG8_SA(1, 1), a1 + hstep, voffA);
            PG8_WAIT_V(8); PG8_WAIT_L(0); PG8_BAR; PG8_MMA(0, 0, At, B0); PG8_MMA(0, 1, At, B1); PG8_BAR; PG8_SCHED;
            PG8_LDA(At, 0, 1); PG8_STAGE(PG8_SB(0, 0), b2, voffB); PG8_STAGE(PG8_SB(0, 1), b2 + hstep, voffB); PG8_STAGE(PG8_SA(0, 0), a2, voffA);
            PG8_WAIT_V(8); PG8_WAIT_L(0); PG8_BAR; PG8_MMA(1, 0, At, B0); PG8_MMA(1, 1, At, B1); PG8_BAR; PG8_SCHED;
            PG8_LDB(B0, 1, 0); PG8_LDB(B1, 1, 1); PG8_SCHED; PG8_LDA(At, 1, 0); PG8_STAGE(PG8_SA(0, 1), a2 + hstep, voffA);
            PG8_WAIT_V(8); PG8_WAIT_L(0); PG8_BAR; PG8_MMA(0, 0, At, B0); PG8_MMA(0, 1, At, B1); PG8_BAR; PG8_SCHED;
            PG8_LDA(At, 1, 1); PG8_STAGE(PG8_SB(1, 0), b3, voffB); PG8_STAGE(PG8_SB(1, 1), b3 + hstep, voffB); PG8_STAGE(PG8_SA(1, 0), a3, voffA);
            PG8_WAIT_V(8); PG8_WAIT_L(0); PG8_BAR; PG8_MMA(1, 0, At, B0); PG8_MMA(1, 1, At, B1); PG8_BAR; PG8_SCHED;
            } else {
            PG8_LDB(B0, 0, 0); PG8_SCHED; PG8_LDA(At, 0, 0); PG8_STAGE(PG8_SA(1, 1), a1 + hstep, voffA);
            PG8_WAIT_L(8); PG8_BAR; PG8_WAIT_L(0); PG8_MMA(0, 0, At, B0); PG8_BAR; PG8_SCHED;
            PG8_LDB(B1, 0, 1); PG8_STAGE(PG8_SB(0, 0), b2, voffB);
            PG8_BAR; PG8_WAIT_L(0); PG8_MMA(0, 1, At, B1); PG8_BAR;
            PG8_LDA(At, 0, 1); PG8_STAGE(PG8_SA(0, 0), a2, voffA);
            PG8_BAR; PG8_WAIT_L(0); PG8_MMA(1, 0, At, B0); PG8_BAR; PG8_SCHED;
            PG8_STAGE(PG8_SB(0, 1), b2 + hstep, voffB);
            PG8_WAIT_V(6); PG8_BAR; PG8_MMA(1, 1, At, B1); PG8_BAR;
            PG8_LDB(B0, 1, 0); PG8_SCHED; PG8_LDA(At, 1, 0); PG8_STAGE(PG8_SA(0, 1), a2 + hstep, voffA);
            PG8_WAIT_L(8); PG8_BAR; PG8_WAIT_L(0); PG8_MMA(0, 0, At, B0); PG8_BAR; PG8_SCHED;
            PG8_LDB(B1, 1, 1); PG8_STAGE(PG8_SB(1, 0), b3, voffB);
            PG8_BAR; PG8_WAIT_L(0); PG8_MMA(0, 1, At, B1); PG8_BAR;
            PG8_LDA(At, 1, 1); PG8_STAGE(PG8_SA(1, 0), a3, voffA);
            PG8_BAR; PG8_WAIT_L(0); PG8_MMA(1, 0, At, B0); PG8_BAR; PG8_SCHED;
            PG8_STAGE(PG8_SB(1, 1), b3 + hstep, voffB);
            PG8_WAIT_V(6); PG8_BAR; PG8_MMA(1, 1, At, B1); PG8_BAR;
            }
        }
        if constexpr (ALIGN_EPI) { if (wr == 0) PG8_BAR; }
        if constexpr (!Epi::AFTER_DRAIN) { E(acc, cur, wr, wc, fr, fq); S.done(cur); }
        if (!has_next) break;
#pragma unroll
        for (int a = 0; a < 2; ++a)
#pragma unroll
            for (int b = 0; b < 2; ++b)
#pragma unroll
                for (int m = 0; m < 4; ++m)
#pragma unroll
                    for (int n = 0; n < 2; ++n) acc[a][b][m][n] = (f32x4){0.f, 0.f, 0.f, 0.f};
        cur = nxt; cA = nA; cB = nB; ++ui;
        if constexpr (ALIGN_EPI) { if (wr == 1) PG8_BAR; }
    }
    PG8_WAIT_V(0);
    if constexpr (!ALIGN_EPI) { if (wr == 0) PG8_BAR; }
    PG8_BAR;
    if constexpr (Epi::AFTER_DRAIN) { E.fused(acc, cur, wr, wc, fr, fq, lds, wid, lane); S.done(cur); }
#undef PG8_SA
#undef PG8_SB
#undef PG8_STAGE
#undef PG8_LDA
#undef PG8_LDB
#undef PG8_MMA
#undef PG8_WAIT_V
#undef PG8_WAIT_L
#undef PG8_BAR
#undef PG8_SCHED
}
}
#define GAS __attribute__((address_space(1)))
#define LAS __attribute__((address_space(3)))
typedef unsigned short bf16;
typedef unsigned v4u __attribute__((ext_vector_type(4)));
typedef float f32x4 __attribute__((ext_vector_type(4)));
typedef short bf16x8 __attribute__((ext_vector_type(8)));
typedef GAS unsigned gu32;
typedef GAS unsigned long long gu64;
#define RLX_AGENT __ATOMIC_RELAXED, __HIP_MEMORY_SCOPE_AGENT
#define LDS_WAIT() asm volatile("s_waitcnt lgkmcnt(0)" ::: "memory")
#define VM_WAIT() asm volatile("s_waitcnt vmcnt(0)" ::: "memory")
__device__ __forceinline__ unsigned long long rt() { return __builtin_amdgcn_s_memrealtime(); }
__device__ __forceinline__ unsigned f2bf(float f) { unsigned u = __builtin_bit_cast(unsigned, f); return (u + 0x7fffu + ((u >> 16) & 1u)) >> 16; }
__device__ __forceinline__ unsigned pk2(float lo, float hi) { return f2bf(lo) | (f2bf(hi) << 16); }
#define XB_TMO      128
#define XB_XCNT(j)  (256  + 64 * (j))
#define XB_XSUB(j)  (1280 + 64 * (j))
#define XB_XGEN(j)  (2304 + 64 * (j))
#define XB_TOP      3328
#define XB_TOPGEN   3392
#define XCD_BAR_WORDS 3456
#define XB_SPIN_CAP (1u << 18)

__device__ __forceinline__ unsigned xb_ld(unsigned* p)              { return __hip_atomic_load(p, __ATOMIC_RELAXED, __HIP_MEMORY_SCOPE_AGENT); }
__device__ __forceinline__ unsigned xb_add(unsigned* p, unsigned v) { return __hip_atomic_fetch_add(p, v, __ATOMIC_RELAXED, __HIP_MEMORY_SCOPE_AGENT); }
__device__ __forceinline__ unsigned xb_xcc_id() { return (unsigned)__builtin_amdgcn_s_getreg((3 << 11) | 20) & 0xFu; }
#define XB_SPIN(cond, bar) do { unsigned _sp = 0; while (cond) { __builtin_amdgcn_s_sleep(1); \
    if ((++_sp & 255u) == 0u) { if (xb_ld(&(bar)[XB_TMO])) break; if (_sp > XB_SPIN_CAP) { atomicAdd(&(bar)[XB_TMO], 1u); break; } } } } while (0)

struct XcdBarrier {
    unsigned* bar; unsigned x;
    volatile LAS unsigned* st;
};

__device__ __forceinline__ XcdBarrier xcd_barrier_post(unsigned* bar, volatile LAS unsigned* st) {
    XcdBarrier b; b.bar = bar; b.x = xb_xcc_id(); b.st = st;
    if (threadIdx.x == 0) (void)xb_add(&bar[XB_XCNT(b.x)], 1u);
    return b;
}
__device__ __forceinline__ void xcd_barrier_complete(unsigned* bar, unsigned x, unsigned& nloc, unsigned& nx) {
    const unsigned G = gridDim.x * gridDim.y * gridDim.z;
    unsigned sum, cnt, mine, sp = 0u;
    for (;;) {
        sum = 0u; cnt = 0u; mine = 0u;
#pragma unroll
        for (unsigned j = 0; j < 16; ++j) { const unsigned c = xb_ld(&bar[XB_XCNT(j)]); sum += c; cnt += (c > 0u) ? 1u : 0u; mine = (j == x) ? c : mine; }
        if (sum == G) break;
        __builtin_amdgcn_s_sleep(1);
        if ((++sp & 255u) == 0u) { if (xb_ld(&bar[XB_TMO])) break; if (sp > XB_SPIN_CAP) { atomicAdd(&bar[XB_TMO], 1u); break; } }
    }
    nloc = mine > 0u ? mine : 1u; nx = cnt > 0u ? cnt : 1u;
}

__device__ __forceinline__ void xcd_barrier(const XcdBarrier& b) {
    asm volatile("s_waitcnt vmcnt(0)" ::: "memory");
    __syncthreads();
    if (threadIdx.x == 0) {
        unsigned* bar = b.bar;
        __builtin_amdgcn_s_waitcnt(0);
        unsigned nloc = b.st[0], nx = b.st[1];
        if (nloc == 0u) { xcd_barrier_complete(bar, b.x, nloc, nx); b.st[0] = nloc; b.st[1] = nx; }
        const unsigned old = xb_add(&bar[XB_XSUB(b.x)], 1u);
        const unsigned gen = old / nloc;
        if (old + 1u == (gen + 1u) * nloc) {
            __builtin_amdgcn_fence(__ATOMIC_RELEASE, "agent");
            asm volatile("s_waitcnt vmcnt(0)" ::: "memory");
            const unsigned og = xb_add(&bar[XB_TOP], 1u);
            const unsigned tg = og / nx;
            if (og + 1u == (tg + 1u) * nx) xb_add(&bar[XB_TOPGEN], 1u);
            else XB_SPIN(xb_ld(&bar[XB_TOPGEN]) == tg, bar);
            __builtin_amdgcn_fence(__ATOMIC_ACQUIRE, "agent");
            xb_add(&bar[XB_XGEN(b.x)], 1u);
            asm volatile("s_waitcnt vmcnt(0)" ::: "memory");
        } else {
            XB_SPIN(xb_ld(&bar[XB_XGEN(b.x)]) == gen, bar);
            __builtin_amdgcn_fence(__ATOMIC_ACQUIRE, "agent");
            asm volatile("s_waitcnt vmcnt(0)" ::: "memory");
        }
    }
    __syncthreads();
}
typedef float f32x2v __attribute__((ext_vector_type(2)));
constexpr int NWAVES = 8;
constexpr int D = 2048, T = 8192, CTX = 256, MT = T + CTX, FF = 5632, INC = 8192, HW = 1024, NMOD = 9;
constexpr float EPS = 1e-6f;
constexpr int N_PHASES = 15;
#ifndef MK_N_LAUNCHES
#define MK_N_LAUNCHES 1
#endif

constexpr size_t MiB = 1u << 20;
constexpr size_t WS_CTL = 0, CTL_ZERO_BYTES = 1 * MiB;
constexpr size_t WS_MOD = 256 * 1024;
constexpr size_t WS_TAB = 1 * MiB;
constexpr size_t WS_W1 = 2 * MiB, WS_WD1 = 46 * MiB, WS_WIN = 68 * MiB, WS_WOUT = 100 * MiB, WS_W2 = 108 * MiB, WS_WD2 = 152 * MiB;
constexpr size_t WS_U = 174 * MiB;
constexpr size_t WS_HC = 207 * MiB;
constexpr size_t WS_P = 209 * MiB;
constexpr size_t P_BF = (size_t)MT * HW * 2, P_F32 = (size_t)MT * HW * 4;
constexpr size_t WS_HQ = WS_P, WS_HK0 = WS_HQ + P_BF, WS_HK1 = WS_HK0 + P_BF, WS_HV = WS_HK1 + P_BF, WS_HG = WS_HV + P_BF, WS_NQ = WS_HG + P_BF, WS_NK = WS_NQ + P_BF, WS_NV = WS_NK + P_BF,
                 WS_LF0 = WS_NV + P_BF, WS_LF1 = WS_LF0 + P_F32, WS_PEND = WS_LF1 + P_F32;
constexpr size_t WS_HID = WS_P;
constexpr size_t WS_MX = 408 * MiB;
constexpr size_t WS_END = WS_MX + 97 * MiB;
static_assert(WS_PEND <= WS_MX && WS_HID + (size_t)MT * FF * 2 <= WS_MX && WS_U + (size_t)MT * D * 2 <= WS_HC && WS_WD2 + (size_t)D * FF * 2 <= WS_U, "d_ws map");
constexpr int CW_BAR = 4096;

constexpr int RING_OFF = 0, SCR_BYTES = 139264;
constexpr int MISC_OFF = SCR_BYTES;
constexpr int LDS_BYTES = 147456;

struct Frame {
    LAS unsigned char* lds;
    volatile LAS unsigned* MISC;
    gu32* ctl;
    int tid, lane, wave, vcu, G;
    const float* in[19]; float* out; unsigned char* ws;
};
__device__ __forceinline__ float wave_sum(float v) {
#pragma unroll
    for (int o = 1; o < 64; o <<= 1) v += __shfl_xor(v, o);
    return v;
}
__device__ __forceinline__ float wave_max(float v) {
#pragma unroll
    for (int o = 1; o < 64; o <<= 1) v = fmaxf(v, __shfl_xor(v, o));
    return v;
}
__device__ __forceinline__ float bf2f(unsigned short b) { return __builtin_bit_cast(float, (unsigned)b << 16); }
__device__ __forceinline__ float bflo(unsigned w) { return __builtin_bit_cast(float, w << 16); }
__device__ __forceinline__ float bfhi(unsigned w) { return __builtin_bit_cast(float, w & 0xffff0000u); }
__device__ __forceinline__ float silu_d(float v) { return v / (1.0f + __expf(-v)); }

__device__ __forceinline__ int dst_row(int kind, int n) {
    if (kind == 0) return n;
    if (kind == 1) return 256 * (n >> 7) + (n & 127);
    if (kind == 2) return 256 * (n >> 7) + 128 + (n & 127);
    const int grp = n >> 10;
    if (grp != 5 && grp != 6) return n;
    const int head = (n & 1023) >> 7, dim = n & 127, half = dim >> 6, bj = (dim & 63) >> 5, i = dim & 31;
    return grp * 1024 + 256 * (head >> 1) + 128 * bj + 32 * (2 * (head & 1) + half) + i;
}
__device__ __forceinline__ void conv_item(const float* W, int K, int N, bf16* WT, int kind, LAS float* scr, int item, int lane) {
    const int nblk = N >> 6, kb = item / nblk, nb = item - kb * nblk, k0 = 64 * kb, n0 = 64 * nb;
    const GAS f32x4* src = (const GAS f32x4*)(W + (size_t)(k0 + (lane >> 4)) * N + n0 + 4 * (lane & 15));
#pragma unroll
    for (int i = 0; i < 16; ++i) { const f32x4 v = src[(size_t)i * N]; *(LAS f32x4*)(scr + ((lane >> 4) + 4 * i) * 68 + 4 * (lane & 15)) = v; }
    LDS_WAIT(); asm volatile("" ::: "memory");
    GAS v4u* dst = (GAS v4u*)(WT + (size_t)dst_row(kind, n0 + lane) * K + k0);
#pragma unroll
    for (int c = 0; c < 8; ++c) { const LAS float* s = scr + (8 * c) * 68 + lane;
        v4u o; o.x = pk2(s[0 * 68], s[1 * 68]); o.y = pk2(s[2 * 68], s[3 * 68]); o.z = pk2(s[4 * 68], s[5 * 68]); o.w = pk2(s[6 * 68], s[7 * 68]); dst[c] = o; }
    LDS_WAIT(); asm volatile("" ::: "memory");
}
__device__ __forceinline__ void p0_prologue(Frame& F) {
    LAS float* scr = (LAS float*)(F.lds + RING_OFF + F.wave * 17408);
    const int gw = F.vcu * NWAVES + F.wave, NGW = F.G * NWAVES, lane = F.lane;
    unsigned char* ws = F.ws;
    float* tab = (float*)(ws + WS_TAB);
    for (int i = gw * 64 + lane; i < 4096; i += NGW * 64) { const int pos = i >> 5, fi = i & 31; const float inv = powf(10000.0f, -(float)fi / 32.0f); const float ang = (float)pos * inv; tab[i] = cosf(ang); tab[4096 + i] = sinf(ang); }
    for (int i = gw * 64 + lane; i < 2048; i += NGW * 64) { const int d = i >> 10, c = i & 1023; const float* lg = F.in[11] + d * 2048 + c; const float a = lg[0], b = lg[1024]; tab[16384 + i] = 1.0f / (1.0f + expf(b - a)); }
    {
        const float* wm = F.in[4]; float* mod = (float*)(ws + WS_MOD);
        for (int it = gw; it < 64 * 72; it += NGW) {
            const int kb = it / 72, cb = it - kb * 72, k0 = 32 * kb, col = 256 * cb + 4 * lane;
            const float sl = silu_d(F.in[1][k0 + (lane & 31)]), sc = silu_d(F.in[3][k0 + (lane & 31)]);
            f32x4 al = (f32x4){0.f, 0.f, 0.f, 0.f}, ac = al;
            if (kb == 0) { al = *(const GAS f32x4*)(F.in[5] + col); ac = al; }
            const GAS f32x4* wp = (const GAS f32x4*)(wm + (size_t)k0 * (NMOD * D) + col);
#pragma unroll 8
            for (int kk = 0; kk < 32; ++kk) { const f32x4 w = wp[(size_t)kk * (NMOD * D / 4)]; const float a = __shfl(sl, kk), b = __shfl(sc, kk); al += w * a; ac += w * b; }
#pragma unroll
            for (int e = 0; e < 4; ++e) { atomicAdd(mod + col + e, al[e]); atomicAdd(mod + NMOD * D + col + e, ac[e]); }
        }
    }
    constexpr int I_GU = (D / 64) * (FF / 64), I_DN = (FF / 64) * (D / 64), I_IN = (D / 64) * (INC / 64), I_OUT = (D / 64) * (D / 64);
    constexpr int NITEMS = 6 * I_GU + I_IN + I_OUT;
    static_assert(I_GU == I_DN, "");
    for (int it = gw; it < NITEMS; it += NGW) {
        int r = it;
        if (r < I_GU) { conv_item(F.in[7], D, FF, (bf16*)(ws + WS_W1), 1, scr, r, lane); continue; } r -= I_GU;
        if (r < I_GU) { conv_item(F.in[8], D, FF, (bf16*)(ws + WS_W1), 2, scr, r, lane); continue; } r -= I_GU;
        if (r < I_DN) { conv_item(F.in[9], FF, D, (bf16*)(ws + WS_WD1), 0, scr, r, lane); continue; } r -= I_DN;
        if (r < I_IN) { conv_item(F.in[10], D, INC, (bf16*)(ws + WS_WIN), 3, scr, r, lane); continue; } r -= I_IN;
        if (r < I_OUT) { conv_item(F.in[14], D, D, (bf16*)(ws + WS_WOUT), 0, scr, r, lane); continue; } r -= I_OUT;
        if (r < I_GU) { conv_item(F.in[15], D, FF, (bf16*)(ws + WS_W2), 1, scr, r, lane); continue; } r -= I_GU;
        if (r < I_GU) { conv_item(F.in[16], D, FF, (bf16*)(ws + WS_W2), 2, scr, r, lane); continue; } r -= I_GU;
        conv_item(F.in[17], FF, D, (bf16*)(ws + WS_WD2), 0, scr, r, lane);
    }
}
__device__ __forceinline__ void norm_mod_phase(Frame& F, const float* src_l, const float* src_c, int nrows, int nwj, int shj, int scj) {
    const int gw = F.vcu * NWAVES + F.wave, NGW = F.G * NWAVES;
    const float* mod = (const float*)(F.ws + WS_MOD); bf16* U = (bf16*)(F.ws + WS_U);
    for (int row = gw; row < nrows; row += NGW) {
        const bool isc = row >= T; const float* hr = isc ? src_c + (size_t)(row - T) * D : src_l + (size_t)row * D; const float* mv = mod + (isc ? NMOD * D : 0);
        const GAS f32x4* xr = (const GAS f32x4*)hr + F.lane;
        f32x4 v[8]; float s = 0.f;
#pragma unroll
        for (int j = 0; j < 8; ++j) { v[j] = xr[64 * j]; s += (v[j].x * v[j].x + v[j].y * v[j].y) + (v[j].z * v[j].z + v[j].w * v[j].w); }
        const float rs = 1.0f / sqrtf(wave_sum(s) * (1.0f / D) + EPS);
        GAS unsigned long long* o8 = (GAS unsigned long long*)(U + (size_t)row * D) + F.lane;
#pragma unroll
        for (int j = 0; j < 8; ++j) { const int col = 4 * F.lane + 256 * j;
            const f32x4 nw = *(const GAS f32x4*)(F.in[6] + nwj * D + col), sc = *(const GAS f32x4*)(mv + scj * D + col), sh = *(const GAS f32x4*)(mv + shj * D + col);
            const f32x4 o = v[j] * rs * nw * (sc + 1.0f) + sh;
            o8[64 * j] = (unsigned long long)pk2(o.x, o.y) | ((unsigned long long)pk2(o.z, o.w) << 32); }
    }
}
__device__ __forceinline__ void final_norm_phase(Frame& F) {
    const int gw = F.vcu * NWAVES + F.wave, NGW = F.G * NWAVES;
    for (int row = gw; row < T; row += NGW) {
        GAS f32x4* xr = (GAS f32x4*)(F.out + (size_t)row * D) + F.lane;
        f32x4 v[8]; float s = 0.f;
#pragma unroll
        for (int j = 0; j < 8; ++j) { v[j] = xr[64 * j]; s += (v[j].x * v[j].x + v[j].y * v[j].y) + (v[j].z * v[j].z + v[j].w * v[j].w); }
        const float rs = 1.0f / sqrtf(wave_sum(s) * (1.0f / D) + EPS);
#pragma unroll
        for (int j = 0; j < 8; ++j) { const f32x4 fw = *(const GAS f32x4*)(F.in[18] + 4 * F.lane + 256 * j); xr[64 * j] = v[j] * rs * fw; }
    }
}
typedef short s16x4 __attribute__((ext_vector_type(4)));
__device__ __forceinline__ s16x4 lds_tr(const LAS unsigned char* p) { return __builtin_amdgcn_ds_read_tr16_b64_v4i16((LAS s16x4*)p); }
__device__ __forceinline__ f32x4 mfma16(bf16x8 a, bf16x8 b, f32x4 c) { return __builtin_amdgcn_mfma_f32_16x16x32_bf16(a, b, c, 0, 0, 0); }
constexpr int HG_QH = 0, HG_KT = 16384, HG_KTT = 32768, HG_VN = 49152, HG_SP = 65536, HG_PM = 98304, HG_DEC = 106496, HG_CS = 107520;
constexpr size_t WS_OF = WS_MX, WS_ST = WS_MX + 64 * MiB, WS_DT = WS_ST + 32 * MiB;
template <bool FULL>
__device__ __forceinline__ void hg_chunk(Frame& F, int hd, int c) {
    const int tid = F.tid, lane = F.lane, w = F.wave, n = lane & 15, g = lane >> 4, head = hd >> 1, dir = hd & 1;
    unsigned char* ws = F.ws; LAS unsigned char* L = F.lds;
    const bf16* HQ = (const bf16*)(ws + WS_HQ); const bf16* HK = (const bf16*)(ws + (dir ? WS_HK1 : WS_HK0)); const float* LF = (const float*)(ws + (dir ? WS_LF1 : WS_LF0)); const bf16* HV = (const bf16*)(ws + WS_HV);
    float* OF = (float*)(ws + WS_OF) + (size_t)dir * T * HW; float* ST = (float*)(ws + WS_ST); float* DT = (float*)(ws + WS_DT);
    const int tc = dir ? 32 - c : c - 1, row0 = c == 0 ? T : 256 * tc;
    f32x4 sacc[8];
    if (FULL) { const float* sp = ST + ((size_t)(hd * 32 + (c - 1)) * 128) * 128 + 16 * w + n;
#pragma unroll
        for (int dt = 0; dt < 8; ++dt)
#pragma unroll
            for (int i = 0; i < 4; ++i) sacc[dt][i] = sp[(size_t)(16 * dt + 4 * g + i) * 128]; }
    else {
#pragma unroll
        for (int dt = 0; dt < 8; ++dt) sacc[dt] = (f32x4){0.f, 0.f, 0.f, 0.f}; }
    float dtot0 = 0.f, dtot1 = 0.f;
    const int dp = lane, tg = w;
    for (int jj = 0; jj < 4; ++jj) {
        const int j = dir ? 3 - jj : jj, r0 = row0 + 64 * j;
        float lf0[8], lf1[8]; unsigned q2[8], k2[8];
#pragma unroll
        for (int e = 0; e < 8; ++e) { const size_t o = (size_t)(r0 + 8 * tg + e) * HW + head * 128 + 2 * dp;
            const f32x2v t = *(const GAS f32x2v*)(LF + o); lf0[e] = t.x; lf1[e] = t.y; k2[e] = *(const GAS unsigned*)(HK + o); if (FULL) q2[e] = *(const GAS unsigned*)(HQ + o); }
        v4u vreg[2];
#pragma unroll
        for (int p = 0; p < 2; ++p) { const int ch = tid + 512 * p; vreg[p] = *(const GAS v4u*)(HV + (size_t)(r0 + (ch >> 4)) * HW + head * 128 + (ch & 15) * 8); }
        float b0[8], b1[8]; float run0 = 0.f, run1 = 0.f;
        if (dir == 0) {
#pragma unroll
            for (int e = 0; e < 8; ++e) { run0 += lf0[e]; run1 += lf1[e]; b0[e] = run0; b1[e] = run1; } }
        else {
#pragma unroll
            for (int e = 7; e >= 0; --e) { run0 += lf0[e]; run1 += lf1[e]; b0[e] = run0; b1[e] = run1; } }
        __syncthreads();
        *(LAS f32x2v*)(L + HG_CS + (tg * 128 + 2 * dp) * 4) = (f32x2v){run0, run1};
        __syncthreads();
        float off0 = 0.f, off1 = 0.f, mid0 = 0.f, mid1 = 0.f, bc0 = 0.f, bc1 = 0.f;
#pragma unroll
        for (int x = 0; x < 8; ++x) { const f32x2v t = *(const LAS f32x2v*)(L + HG_CS + (x * 128 + 2 * dp) * 4);
            const bool inoff = dir ? (x > tg) : (x < tg), inmid = dir ? (x >= 4) : (x < 4);
            off0 += inoff ? t.x : 0.f; off1 += inoff ? t.y : 0.f; mid0 += inmid ? t.x : 0.f; mid1 += inmid ? t.y : 0.f; bc0 += t.x; bc1 += t.y; }
        unsigned kt[8];
#pragma unroll
        for (int e = 0; e < 8; ++e) { const float bb0 = b0[e] + off0, bb1 = b1[e] + off1; const int tau = 8 * tg + e;
            const float ek0 = __expf(fminf(mid0 - bb0, 60.f)), ek1 = __expf(fminf(mid1 - bb1, 60.f));
            kt[e] = pk2(bflo(k2[e]) * ek0, bfhi(k2[e]) * ek1);
            if (FULL) { const float eq0 = __expf(fminf(bb0 - mid0, 60.f)), eq1 = __expf(fminf(bb1 - mid1, 60.f));
                const int bo = tau * 256 + (((dp >> 2) ^ (tau & 15)) << 4) + (dp & 3) * 4;
                *(LAS unsigned*)(L + HG_QH + bo) = pk2(bflo(q2[e]) * eq0, bfhi(q2[e]) * eq1); *(LAS unsigned*)(L + HG_KT + bo) = kt[e]; } }
        {
            v4u lo, hi;
            lo.x = (kt[0] & 0xffffu) | (kt[1] << 16); lo.y = (kt[2] & 0xffffu) | (kt[3] << 16); lo.z = (kt[4] & 0xffffu) | (kt[5] << 16); lo.w = (kt[6] & 0xffffu) | (kt[7] << 16);
            hi.x = (kt[0] >> 16) | (kt[1] & 0xffff0000u); hi.y = (kt[2] >> 16) | (kt[3] & 0xffff0000u); hi.z = (kt[4] >> 16) | (kt[5] & 0xffff0000u); hi.w = (kt[6] >> 16) | (kt[7] & 0xffff0000u);
            const int d0 = 2 * dp; const int sw = (tg ^ (dp & 7)) << 4;
            *(LAS v4u*)(L + HG_KTT + d0 * 128 + sw) = lo; *(LAS v4u*)(L + HG_KTT + (d0 + 1) * 128 + sw) = hi; }
        if (tg == 0) { *(LAS f32x2v*)(L + HG_DEC + 2 * dp * 4) = (f32x2v){__expf(mid0), __expf(mid1)}; *(LAS f32x2v*)(L + HG_DEC + 512 + 2 * dp * 4) = (f32x2v){__expf(bc0 - mid0), __expf(bc1 - mid1)}; }
        dtot0 += bc0; dtot1 += bc1;
#pragma unroll
        for (int p = 0; p < 2; ++p) { const int ch = tid + 512 * p, row = ch >> 4, cc = ch & 15, fr_ = (row & 3) | ((row >> 1) & 4);
            *(LAS v4u*)(L + HG_VN + row * 256 + ((((cc >> 1) ^ fr_) << 5) | ((cc & 1) << 4))) = vreg[p]; }
        __syncthreads();
#pragma unroll
        for (int dt = 0; dt < 8; ++dt) { const f32x4 dm = *(const LAS f32x4*)(L + HG_DEC + (16 * dt + 4 * g) * 4); sacc[dt] *= dm; }
        if (FULL) {
            const int v = 16 * w + n;
#pragma unroll
            for (int dt = 0; dt < 8; ++dt) { const unsigned long long pk = (unsigned long long)pk2(sacc[dt][0], sacc[dt][1]) | ((unsigned long long)pk2(sacc[dt][2], sacc[dt][3]) << 32);
                *(LAS unsigned long long*)(L + HG_SP + v * 256 + (((2 * dt + (g >> 1)) ^ (v & 15)) << 4) + 8 * (g & 1)) = pk; }
#pragma unroll
            for (int x = 0; x < 2; ++x) { const int id = 2 * w + x, tt = id >> 2, st = id & 3; const int rs_ = 16 * st + n, rt_ = 16 * tt + n;
                f32x4 a = (f32x4){0.f, 0.f, 0.f, 0.f};
#pragma unroll
                for (int kk = 0; kk < 4; ++kk) { const bf16x8 kf = *(const LAS bf16x8*)(L + HG_KT + rs_ * 256 + (((g + 4 * kk) ^ (rs_ & 15)) << 4)), qf = *(const LAS bf16x8*)(L + HG_QH + rt_ * 256 + (((g + 4 * kk) ^ (rt_ & 15)) << 4));
                    a = mfma16(kf, qf, a); }
                const int tau = 16 * tt + n, s0 = 16 * st + 4 * g;
#pragma unroll
                for (int i = 0; i < 4; ++i) { const bool keep = dir ? (s0 + i >= tau) : (s0 + i <= tau); a[i] = keep ? a[i] : 0.f; }
                const unsigned long long pk = (unsigned long long)pk2(a[0], a[1]) | ((unsigned long long)pk2(a[2], a[3]) << 32);
                *(LAS unsigned long long*)(L + HG_PM + tau * 128 + (((2 * st + (g >> 1)) ^ ((tau >> 1) & 7)) << 4) + 8 * (g & 1)) = pk; }
            __syncthreads();
        }
        bf16x8 vf[2];
#pragma unroll
        for (int kp = 0; kp < 2; ++kp) { const int ra = 32 * kp + 8 * g + (n >> 2), rb = ra + 4; const int fa = (ra & 3) | ((ra >> 1) & 4), fb = (rb & 3) | ((rb >> 1) & 4);
            const s16x4 ta = lds_tr(L + HG_VN + ra * 256 + ((w ^ fa) << 5) + 8 * (n & 3)), tb = lds_tr(L + HG_VN + rb * 256 + ((w ^ fb) << 5) + 8 * (n & 3));
            vf[kp] = (bf16x8){ta[0], ta[1], ta[2], ta[3], tb[0], tb[1], tb[2], tb[3]}; }
        if (FULL) {
            const int v = 16 * w + n; bf16x8 spf[4];
#pragma unroll
            for (int kk = 0; kk < 4; ++kk) spf[kk] = *(const LAS bf16x8*)(L + HG_SP + v * 256 + (((g + 4 * kk) ^ (v & 15)) << 4));
#pragma unroll
            for (int tt = 0; tt < 4; ++tt) { const int tau = 16 * tt + n; f32x4 o = (f32x4){0.f, 0.f, 0.f, 0.f};
#pragma unroll
                for (int kp = 0; kp < 2; ++kp) { const bf16x8 pf = *(const LAS bf16x8*)(L + HG_PM + tau * 128 + (((g + 4 * kp) ^ ((tau >> 1) & 7)) << 4)); o = mfma16(pf, vf[kp], o); }
#pragma unroll
                for (int kk = 0; kk < 4; ++kk) { const bf16x8 qf = *(const LAS bf16x8*)(L + HG_QH + tau * 256 + (((g + 4 * kk) ^ (tau & 15)) << 4)); o = mfma16(qf, spf[kk], o); }
                float* op = OF + (size_t)(r0 + 16 * tt + 4 * g) * HW + head * 128 + 16 * w + n;
#pragma unroll
                for (int i = 0; i < 4; ++i) op[(size_t)i * HW] = o[i]; }
        }
#pragma unroll
        for (int dt = 0; dt < 8; ++dt) { const int d = 16 * dt + n;
#pragma unroll
            for (int kp = 0; kp < 2; ++kp) { const bf16x8 kf = *(const LAS bf16x8*)(L + HG_KTT + d * 128 + (((g + 4 * kp) ^ ((d >> 1) & 7)) << 4)); sacc[dt] = mfma16(kf, vf[kp], sacc[dt]); }
            const f32x4 de = *(const LAS f32x4*)(L + HG_DEC + 512 + (16 * dt + 4 * g) * 4); sacc[dt] *= de; }
    }
    if (!FULL) { float* sp = ST + ((size_t)(hd * 32 + c) * 128) * 128 + 16 * w + n;
#pragma unroll
        for (int dt = 0; dt < 8; ++dt)
#pragma unroll
            for (int i = 0; i < 4; ++i) sp[(size_t)(16 * dt + 4 * g + i) * 128] = sacc[dt][i];
        if (tg == 0) *(GAS f32x2v*)(DT + (size_t)(hd * 32 + c) * 128 + 2 * dp) = (f32x2v){__expf(dtot0), __expf(dtot1)}; }
}
__device__ __forceinline__ void hg_scan(Frame& F) {
    float* ST = (float*)(F.ws + WS_ST); const float* DT = (const float*)(F.ws + WS_DT);
    for (int gid = F.vcu * (NWAVES * 64) + F.tid; gid < 16 * 128 * 64; gid += F.G * NWAVES * 64) {
        const int hd = gid >> 13, d = (gid >> 6) & 127, v2 = gid & 63;
        GAS f32x2v* sp = (GAS f32x2v*)(ST + ((size_t)(hd * 32) * 128 + d) * 128) + v2; const float* dp_ = DT + (size_t)hd * 32 * 128 + d;
        f32x2v S = (f32x2v){0.f, 0.f};
#pragma unroll 8
        for (int c = 0; c < 32; ++c) { const f32x2v l = sp[(size_t)c * 8192]; const float dc = dp_[c * 128]; S = S * dc + l; sp[(size_t)c * 8192] = S; }
    }
}
__device__ __forceinline__ void na_phase(Frame& F, int first, int stride) {
    const int tid = F.tid, lane = F.lane, wave = F.wave, n = lane & 15, g = lane >> 4, hh = wave >> 2, a = wave & 3;
    unsigned char* ws = F.ws; LAS unsigned char* L = F.lds;
    const bf16* NQ = (const bf16*)(ws + WS_NQ); const bf16* NK = (const bf16*)(ws + WS_NK); const bf16* NV = (const bf16*)(ws + WS_NV); bf16* MIX = (bf16*)(ws + WS_U);
    LAS float* rp = (LAS float*)(L + 131072);
    const unsigned wmask = a == 0 ? 3u : (a == 1 ? 7u : (a == 2 ? 14u : 12u));
    for (int it = first; it < 512; it += stride) {
        const int r = it >> 2, hp = it & 3, h = 2 * hp + hh, rs = min(max(r - 4, 0), 120), t0 = r * 64, cq = 16 * a + n, cs = min(max(cq - 8, 0), 48);
        __syncthreads();
        for (int i = tid; i < 930; i += NWAVES * 64) rp[i] = F.in[13][(2 * hp) * 465 + i];
        bf16x8 qf[4];
        { const bf16* qp = NQ + (size_t)(t0 + 16 * a + n) * HW + h * 128 + 8 * g;
#pragma unroll
          for (int kk = 0; kk < 4; ++kk) qf[kk] = *(const GAS bf16x8*)(qp + 32 * kk); }
        v4u kreg[4], vreg[4];
#define NA_LOAD(t) do { const int tok0_ = (t) < 8 ? (rs + (t)) * 64 : T + ((t) - 8) * 64; \
        _Pragma("unroll") for (int p_ = 0; p_ < 4; ++p_) { const int ch_ = tid + 512 * p_; const size_t go_ = (size_t)(tok0_ + (ch_ >> 5)) * HW + hp * 256 + (ch_ & 31) * 8; \
            kreg[p_] = *(const GAS v4u*)(NK + go_); vreg[p_] = *(const GAS v4u*)(NV + go_); } } while (0)
#define NA_STORE(b) do { _Pragma("unroll") for (int p_ = 0; p_ < 4; ++p_) { const int ch_ = tid + 512 * p_, row_ = ch_ >> 5, hd_ = (ch_ >> 4) & 1, c_ = ch_ & 15; \
            *(LAS v4u*)(L + (b) * 32768 + hd_ * 16384 + row_ * 256 + ((c_ ^ (row_ & 15)) << 4)) = kreg[p_]; \
            *(LAS v4u*)(L + 65536 + (b) * 32768 + hd_ * 16384 + row_ * 256 + ((((c_ >> 1) ^ (row_ & 7)) << 5) | ((c_ & 1) << 4))) = vreg[p_]; } } while (0)
        NA_LOAD(0); NA_STORE(0);
        __syncthreads();
        float m = -1e30f, l = 0.f; f32x4 o[8];
#pragma unroll
        for (int vs = 0; vs < 8; ++vs) o[vs] = (f32x4){0.f, 0.f, 0.f, 0.f};
        for (int t = 0; t < 12; ++t) {
            if (t + 1 < 12) NA_LOAD(t + 1);
            const int b = t & 1; const bool win = t < 8; const unsigned mask = win ? wmask : 15u;
            const LAS unsigned char* Kb = L + b * 32768 + hh * 16384; const LAS unsigned char* Vb = L + 65536 + b * 32768 + hh * 16384;
            f32x4 s[4];
#pragma unroll
            for (int ks = 0; ks < 4; ++ks) {
                s[ks] = (f32x4){0.f, 0.f, 0.f, 0.f};
                if ((mask >> ks) & 1u) {
                    const int row = 16 * ks + n;
#pragma unroll
                    for (int kk = 0; kk < 4; ++kk) { const bf16x8 kf = *(const LAS bf16x8*)(Kb + row * 256 + (((g + 4 * kk) ^ (row & 15)) << 4)); s[ks] = mfma16(kf, qf[kk], s[ks]); }
                }
            }
            float mx = -1e30f;
            const LAS float* rpr = rp + hh * 465 + (rs + t - r + 7) * 31 + 15 - cq;
#pragma unroll
            for (int ks = 0; ks < 4; ++ks)
#pragma unroll
                for (int i = 0; i < 4; ++i) { const int ck = 16 * ks + 4 * g + i; float v = s[ks][i];
                    if (win) { const bool ok = ((mask >> ks) & 1u) && ck >= cs && ck < cs + 16; v = ok ? v + rpr[ok ? ck : cq] : -1e30f; }
                    s[ks][i] = v; mx = fmaxf(mx, v); }
            mx = fmaxf(mx, __shfl_xor(mx, 16)); mx = fmaxf(mx, __shfl_xor(mx, 32));
            const float mn = fmaxf(m, mx), alpha = __expf(m - mn); m = mn;
            float rsum = 0.f;
#pragma unroll
            for (int ks = 0; ks < 4; ++ks)
#pragma unroll
                for (int i = 0; i < 4; ++i) { const float p = __expf(s[ks][i] - mn); s[ks][i] = p; rsum += p; }
            rsum += __shfl_xor(rsum, 16); rsum += __shfl_xor(rsum, 32);
            l = l * alpha + rsum;
#pragma unroll
            for (int vs = 0; vs < 8; ++vs) o[vs] *= alpha;
#pragma unroll
            for (int kp = 0; kp < 2; ++kp) {
                if ((mask >> (2 * kp)) & 3u) {
                    bf16x8 pf; { const unsigned w0 = pk2(s[2 * kp][0], s[2 * kp][1]), w1 = pk2(s[2 * kp][2], s[2 * kp][3]), w2 = pk2(s[2 * kp + 1][0], s[2 * kp + 1][1]), w3 = pk2(s[2 * kp + 1][2], s[2 * kp + 1][3]);
                        const v4u w = (v4u){w0, w1, w2, w3}; pf = __builtin_bit_cast(bf16x8, w); }
                    const int rowA = 32 * kp + 4 * g + (n >> 2);
#pragma unroll
                    for (int vs = 0; vs < 8; ++vs) {
                        const s16x4 ta = lds_tr(Vb + rowA * 256 + ((vs ^ (rowA & 7)) << 5) + 8 * (n & 3));
                        const s16x4 tb = lds_tr(Vb + (rowA + 16) * 256 + ((vs ^ (rowA & 7)) << 5) + 8 * (n & 3));
                        const bf16x8 vf = (bf16x8){ta[0], ta[1], ta[2], ta[3], tb[0], tb[1], tb[2], tb[3]};
                        o[vs] = mfma16(vf, pf, o[vs]);
                    }
                }
            }
            if (t + 1 < 12) NA_STORE((t + 1) & 1);
            __syncthreads();
        }
        const float inv = 1.0f / l;
        bf16* op = MIX + (size_t)(t0 + 16 * a + n) * D + HW + h * 128 + 4 * g;
#pragma unroll
        for (int vs = 0; vs < 8; ++vs) { const f32x4 v = o[vs] * inv; *(GAS unsigned long long*)(op + 16 * vs) = (unsigned long long)pk2(v[0], v[1]) | ((unsigned long long)pk2(v[2], v[3]) << 32); }
#undef NA_LOAD
#undef NA_STORE
    }
}
__device__ __forceinline__ void readout_simple(Frame& F) {
    const int gw = F.vcu * NWAVES + F.wave, NGW = F.G * NWAVES, lane = F.lane; unsigned char* ws = F.ws;
    const float* OF = (const float*)(ws + WS_MX); const bf16* HG = (const bf16*)(ws + WS_HG); bf16* MIX = (bf16*)(ws + WS_U);
    for (int t = gw; t < T; t += NGW) {
        const size_t o = (size_t)t * HW + 16 * lane; float v[16]; float ss = 0.f;
#pragma unroll
        for (int j = 0; j < 4; ++j) { const f32x4 a = *(const GAS f32x4*)(OF + o + 4 * j), b = *(const GAS f32x4*)(OF + (size_t)T * HW + o + 4 * j);
#pragma unroll
            for (int e = 0; e < 4; ++e) { v[4 * j + e] = a[e] + b[e]; ss += v[4 * j + e] * v[4 * j + e]; } }
        ss += __shfl_xor(ss, 1); ss += __shfl_xor(ss, 2); ss += __shfl_xor(ss, 4);
        const float rs = 1.0f / sqrtf(ss * (1.0f / 128.0f) + EPS);
        const v4u g0 = *(const GAS v4u*)(HG + o), g1 = *(const GAS v4u*)(HG + o + 8);
        const unsigned gw_[8] = {g0.x, g0.y, g0.z, g0.w, g1.x, g1.y, g1.z, g1.w};
        const float* nw = F.in[12] + (16 * lane & 127);
        unsigned ow[8];
#pragma unroll
        for (int j = 0; j < 8; ++j) ow[j] = pk2(v[2 * j] * rs * nw[2 * j] * bflo(gw_[j]), v[2 * j + 1] * rs * nw[2 * j + 1] * bfhi(gw_[j]));
        GAS v4u* mp = (GAS v4u*)(MIX + (size_t)t * D + 16 * lane);
        mp[0] = (v4u){ow[0], ow[1], ow[2], ow[3]}; mp[1] = (v4u){ow[4], ow[5], ow[6], ow[7]};
    }
}

struct Args { const float* in[19]; float* out; unsigned char* ws; int ph_lo, ph_hi; };
__global__ void __launch_bounds__(NWAVES * 64, 2) mk_fwd(Args args) {
    extern __shared__ __attribute__((aligned(16))) unsigned char lds[];
    Frame F;
    F.lds = (LAS unsigned char*)lds;
    F.MISC = (volatile LAS unsigned*)(F.lds + MISC_OFF);
    F.tid = threadIdx.x; F.lane = F.tid & 63; F.wave = __builtin_amdgcn_readfirstlane(F.tid >> 6);
    F.G = gridDim.x; { const int bx = blockIdx.x; F.vcu = (F.G % 8 == 0) ? (bx % 8) * (F.G / 8) + bx / 8 : bx; }
    unsigned char* ws = args.ws; F.ws = ws; F.out = args.out;
#pragma unroll
    for (int i = 0; i < 19; ++i) F.in[i] = args.in[i];
    F.ctl = (gu32*)(ws + WS_CTL);
    for (int u = F.tid; u < 32; u += NWAVES * 64) ((LAS unsigned*)(F.lds + MISC_OFF))[u] = 0u;
    __syncthreads();
    const int lo = args.ph_lo, hi = args.ph_hi;
    XcdBarrier bar; bar.bar = (unsigned*)(F.ctl + CW_BAR); bar.x = 0; bar.st = nullptr;
    if (hi - lo > 1) bar = xcd_barrier_post((unsigned*)(F.ctl + CW_BAR), F.MISC + 8);
#define IN(k) (lo <= (k) && (k) < hi)
#define SEAM(k) do { if (IN(k) && IN((k) + 1)) xcd_barrier(bar); } while (0)
    const float* mod = (const float*)(ws + WS_MOD);
    bf16* U = (bf16*)(ws + WS_U); bf16* HID = (bf16*)(ws + WS_HID); float* HC = (float*)(ws + WS_HC);

    if (IN(0)) { p0_prologue(F); } SEAM(0);
    if (IN(1)) { norm_mod_phase(F, F.in[0], F.in[2], MT, 0, 0, 1); } SEAM(1);
    if (IN(2)) {
        pg8::Gemm g{U, (const bf16*)(ws + WS_W1), MT, 2 * FF, D}; pg8::StaticOrder S; S.init(MT, 2 * FF, F.G, (int)blockIdx.x);
        pg8::EpiSwiglu E{HID, FF};
        pg8::gemm_phase<pg8::EpiSwiglu, pg8::StaticOrder, true, true>(F.lds + RING_OFF, g, S, E);
    } SEAM(2);
    if (IN(3)) {
        pg8::Gemm g{HID, (const bf16*)(ws + WS_WD1), MT, D, FF}; pg8::StaticOrder S; S.init(MT, D, F.G, (int)blockIdx.x);
        pg8::EpiResid E{F.in[0], F.in[2], F.out, HC, mod + 2 * D, mod + NMOD * D + 2 * D, 0.5f};
        pg8::gemm_phase<pg8::EpiResid, pg8::StaticOrder, true, true>(F.lds + RING_OFF, g, S, E);
    } SEAM(3);
    if (IN(4)) { norm_mod_phase(F, F.out, HC, MT, 1, 3, 4); } SEAM(4);
    if (IN(5)) {
        pg8::Gemm g{U, (const bf16*)(ws + WS_WIN), MT, INC, D}; pg8::StaticOrder S; S.init(MT, INC, F.G, (int)blockIdx.x);
        pg8::EpiWin E{(bf16*)(ws + WS_HQ), (bf16*)(ws + WS_HK0), (bf16*)(ws + WS_HK1), (float*)(ws + WS_LF0), (float*)(ws + WS_LF1), (bf16*)(ws + WS_HV), (bf16*)(ws + WS_HG),
                      (bf16*)(ws + WS_NQ), (bf16*)(ws + WS_NK), (bf16*)(ws + WS_NV), (const float*)(ws + WS_TAB) + 16384, (const float*)(ws + WS_TAB)};
        pg8::gemm_phase<pg8::EpiWin, pg8::StaticOrder, true, true>(F.lds + RING_OFF, g, S, E);
    } SEAM(5);
    if (IN(6)) { for (int it = F.vcu; it < 512; it += F.G) hg_chunk<false>(F, it & 15, it >> 4); } SEAM(6);
    if (IN(7)) { hg_scan(F); na_phase(F, F.vcu, F.G); } SEAM(7);
    if (IN(8)) { for (int it = F.vcu; it < 512; it += F.G) hg_chunk<true>(F, it & 15, 1 + (it >> 4)); } SEAM(8);
    if (IN(9)) { readout_simple(F); } SEAM(9);
    if (IN(10)) {
        pg8::Gemm g{U, (const bf16*)(ws + WS_WOUT), T, D, D}; pg8::StaticOrder S; S.init(T, D, F.G, (int)blockIdx.x);
        pg8::EpiResid E{F.out, F.out, F.out, F.out, mod + 5 * D, mod + 5 * D, 1.0f};
        pg8::gemm_phase<pg8::EpiResid, pg8::StaticOrder, true, true>(F.lds + RING_OFF, g, S, E);
    } SEAM(10);
    if (IN(11)) { norm_mod_phase(F, F.out, F.out, T, 2, 6, 7); } SEAM(11);
    if (IN(12)) {
        pg8::Gemm g{U, (const bf16*)(ws + WS_W2), T, 2 * FF, D}; pg8::StaticOrder S; S.init(T, 2 * FF, F.G, (int)blockIdx.x);
        pg8::EpiSwiglu E{HID, FF};
        pg8::gemm_phase<pg8::EpiSwiglu, pg8::StaticOrder, true, true>(F.lds + RING_OFF, g, S, E);
    } SEAM(12);
    if (IN(13)) {
        pg8::Gemm g{HID, (const bf16*)(ws + WS_WD2), T, D, FF}; pg8::StaticOrder S; S.init(T, D, F.G, (int)blockIdx.x);
        pg8::EpiResid E{F.out, F.out, F.out, F.out, mod + 8 * D, mod + 8 * D, 0.5f};
        pg8::gemm_phase<pg8::EpiResid, pg8::StaticOrder, true, true>(F.lds + RING_OFF, g, S, E);
    } SEAM(13);
    if (IN(14)) { final_norm_phase(F); }
#undef IN
#undef SEAM
}

extern "C" void kernel_launch(void* const* d_in, const int* in_sizes, int n_in, void* d_out, int out_size, void* d_ws, size_t ws_size, hipStream_t stream) {
    static int grid = 0;
    if (grid == 0) {
        if (n_in != 19 || out_size != T * D || ws_size < WS_END) { fprintf(stderr, "kernel_launch: unexpected shapes: n_in %d out %d ws %zu (need %zu)\n", n_in, out_size, ws_size, (size_t)WS_END); grid = -1; return; }
        int dev = 0, cus = 0, per_cu = 0;
        if (hipGetDevice(&dev) != hipSuccess || hipDeviceGetAttribute(&cus, hipDeviceAttributeMultiprocessorCount, dev) != hipSuccess) { grid = -1; return; }
        if (hipFuncSetAttribute((const void*)mk_fwd, hipFuncAttributeMaxDynamicSharedMemorySize, LDS_BYTES) != hipSuccess) { fprintf(stderr, "kernel_launch: hipFuncSetAttribute failed\n"); grid = -1; return; }
        if (hipOccupancyMaxActiveBlocksPerMultiprocessor(&per_cu, (const void*)mk_fwd, NWAVES * 64, LDS_BYTES) != hipSuccess || per_cu < 1) { fprintf(stderr, "kernel_launch: occupancy query says %d\n", per_cu); per_cu = 1; }
        (void)hipGetLastError();
        grid = cus;
    }
    if (grid < 0) return;
    (void)hipMemsetAsync((char*)d_ws + WS_CTL, 0, CTL_ZERO_BYTES, stream);
    Args a{};
    for (int i = 0; i < 19; ++i) a.in[i] = (const float*)d_in[i];
    a.out = (float*)d_out; a.ws = (unsigned char*)d_ws;
    constexpr int NL = MK_N_LAUNCHES;
    for (int li = 0; li < NL; ++li) {
        a.ph_lo = (NL == 1) ? 0 : li; a.ph_hi = (NL == 1) ? N_PHASES : li + 1;
        if (NL == 1) { void* kargs[] = {&a}; hipError_t e = hipLaunchCooperativeKernel((const void*)mk_fwd, dim3(grid), dim3(NWAVES * 64), kargs, LDS_BYTES, stream);
            if (e != hipSuccess) fprintf(stderr, "cooperative launch failed: %s (grid %d)\n", hipGetErrorString(e), grid); }
        else hipLaunchKernelGGL(mk_fwd, dim3(grid), dim3(NWAVES * 64), LDS_BYTES, stream, a);
    }
}
```

```cpp
#include <hip/hip_runtime.h>
#include <cstdio>
#include <cstdint>
#include <cmath>
namespace pg8 {
#define PG8_LAS __attribute__((address_space(3)))
typedef unsigned short bf16_t;
typedef short bf16x8 __attribute__((ext_vector_type(8)));
typedef float f32x4 __attribute__((ext_vector_type(4)));
typedef unsigned u32x4 __attribute__((ext_vector_type(4)));
constexpr int BM = 256, BK = 64, HALF = 128, HTB = HALF * BK * 2  , STAGE_BYTES = 8 * HTB, NXCD = 8, WGM = 8;

__host__ __device__ __forceinline__ int lds_byte(int r, int c) { const int st = (r >> 4) * 2 + (c >> 5), rr = r & 15, cc = c & 31, ob = rr * 64 + cc * 2; return st * 1024 + (ob ^ (((ob >> 9) & 1) << 5)); }
__host__ __device__ __forceinline__ void stage_rc(int b, int& R, int& C) { const int st = b / 1024, sb = b % 1024, swz = sb ^ (((sb >> 9) & 1) << 5); R = (st >> 1) * 16 + swz / 64; C = (st & 1) * 32 + (swz % 64) / 2; }
__host__ __device__ __forceinline__ int perm32(int rho) { const int n = rho >> 4, i = rho & 15; return 8 * (i >> 2) + 4 * n + (i & 3); }

struct Unit { int pm, pn, koff, nt, split; };
struct Gemm { const bf16_t* A; const bf16_t* Bt; int M, N, K; };

struct StaticOrder {
    int nM, nN, nwg, G, c;
    __host__ __device__ void init(int M, int N, int G_, int c_) { nM = M / BM; nN = N / BM; nwg = nM * nN; G = G_; c = c_; }
    __host__ __device__ bool next(int i, Unit& u) const {
        const long L = (long)i * G + c; if (L >= nwg) return false;
        int wgid = (int)L; { const int q = nwg / NXCD, r = nwg % NXCD, xcd = wgid % NXCD, off = wgid / NXCD; wgid = (xcd < r ? xcd * (q + 1) : r * (q + 1) + (xcd - r) * q) + off; }
        const int nig = WGM * nN, gid = wgid / nig, fm = gid * WGM, gsz = (nM - fm) < WGM ? (nM - fm) : WGM;
        u.pm = fm + ((wgid % nig) % gsz); u.pn = (wgid % nig) / gsz; u.koff = 0; u.nt = 0; u.split = 0; return true;
    }
    __device__ __forceinline__ void a_ready(const Unit&) const {}
    __device__ __forceinline__ void done(const Unit&) const {}
};

__device__ __forceinline__ unsigned cvt_pk_bf16(float lo, float hi) { unsigned r; asm volatile("v_cvt_pk_bf16_f32 %0, %1, %2" : "=v"(r) : "v"(lo), "v"(hi)); return r; }
typedef float f32x2 __attribute__((ext_vector_type(2)));
__device__ __forceinline__ float sigmoid_f(float v) { return __builtin_amdgcn_rcpf(1.0f + __builtin_amdgcn_exp2f(-1.44269504089f * v)); }
__device__ __forceinline__ float silu_f(float v) { return v * sigmoid_f(v); }

struct EpiSwiglu {
    static constexpr bool PERM = true, AFTER_DRAIN = false;
    bf16_t* H; int ldh;
    __device__ __forceinline__ void operator()(const f32x4 (&acc)[2][2][4][2], const Unit& u, int wr, int wc, int fr, int fq) const {
        const int row0 = u.pm * BM + wr * 64 + fr, col0 = u.pn * HALF + wc * 32 + 8 * fq;
#pragma unroll
        for (int ai = 0; ai < 2; ++ai)
#pragma unroll
            for (int m = 0; m < 4; ++m) { bf16_t* rowp = H + (size_t)(row0 + ai * HALF + m * 16) * ldh + col0;
                const f32x4 g0 = acc[ai][0][m][0], g1 = acc[ai][0][m][1], u0 = acc[ai][1][m][0], u1 = acc[ai][1][m][1];
                u32x4 w; w.x = cvt_pk_bf16(silu_f(g0[0]) * u0[0], silu_f(g0[1]) * u0[1]); w.y = cvt_pk_bf16(silu_f(g0[2]) * u0[2], silu_f(g0[3]) * u0[3]);
                w.z = cvt_pk_bf16(silu_f(g1[0]) * u1[0], silu_f(g1[1]) * u1[1]); w.w = cvt_pk_bf16(silu_f(g1[2]) * u1[2], silu_f(g1[3]) * u1[3]);
                *(u32x4*)rowp = w; }
    }
};

struct EpiResid {
    static constexpr bool PERM = false, AFTER_DRAIN = false;
    const float* base_l; const float* base_c; float* out_l; float* out_c; const float* gate_l; const float* gate_c; float coef;
    __device__ __forceinline__ void operator()(const f32x4 (&acc)[2][2][4][2], const Unit& u, int wr, int wc, int fr, int fq) const {
        const bool isc = u.pm >= 32;
        const float* base = isc ? base_c : base_l; float* out = isc ? out_c : out_l; const float* gate = isc ? gate_c : gate_l;
        const int row0 = (isc ? 0 : u.pm * BM) + wr * 64 + fr, col0 = u.pn * BM + wc * 32 + 4 * fq;
        f32x4 gv[2][2];
#pragma unroll
        for (int bj = 0; bj < 2; ++bj)
#pragma unroll
            for (int n = 0; n < 2; ++n) gv[bj][n] = *(const f32x4*)(gate + col0 + bj * HALF + n * 16) * coef;
        if (u.split) {
            float* sl = out + (size_t)(u.koff >> 3) * (256 * 2048);
#pragma unroll
            for (int ai = 0; ai < 2; ++ai)
#pragma unroll
                for (int m = 0; m < 4; ++m) { const size_t off = (size_t)(row0 + ai * HALF + m * 16) * 2048 + col0;
#pragma unroll
                    for (int bj = 0; bj < 2; ++bj)
#pragma unroll
                        for (int n = 0; n < 2; ++n) *(f32x4*)(sl + off + bj * HALF + n * 16) = acc[ai][bj][m][n]; }
            return;
        }
#pragma unroll
        for (int ai = 0; ai < 2; ++ai)
#pragma unroll
            for (int m = 0; m < 4; ++m) { const size_t off = (size_t)(row0 + ai * HALF + m * 16) * 2048 + col0;
#pragma unroll
                for (int bj = 0; bj < 2; ++bj)
#pragma unroll
                    for (int n = 0; n < 2; ++n) { const f32x4 b = *(const f32x4*)(base + off + bj * HALF + n * 16); *(f32x4*)(out + off + bj * HALF + n * 16) = b + gv[bj][n] * acc[ai][bj][m][n]; }
                if (m & 1) asm volatile("" ::: "memory"); }
    }
};

struct EpiWin {
    static constexpr bool PERM = true, AFTER_DRAIN = false;
    bf16_t* HQ; bf16_t* HK0; bf16_t* HK1; float* LF0; float* LF1; bf16_t* HV; bf16_t* HG; bf16_t* NQ; bf16_t* NK; bf16_t* NV;
    const float* lb;
    const float* ropeT;
    __device__ __forceinline__ void st8(bf16_t* p, const f32x4 a, const f32x4 b) const { u32x4 w; w.x = cvt_pk_bf16(a[0], a[1]); w.y = cvt_pk_bf16(a[2], a[3]); w.z = cvt_pk_bf16(b[0], b[1]); w.w = cvt_pk_bf16(b[2], b[3]); *(u32x4*)p = w; }
    __device__ __forceinline__ void operator()(const f32x4 (&acc)[2][2][4][2], const Unit& u, int wr, int wc, int fr, int fq) const {
        const int grp = u.pn >> 2, row0 = u.pm * BM + wr * 64 + fr, gc0 = (u.pn & 3) * BM + wc * 32 + 8 * fq;
        if (grp == 0 || grp == 3 || grp == 4 || grp == 7) {
            bf16_t* O = grp == 0 ? HQ : (grp == 3 ? HV : (grp == 4 ? HG : NV)); const bool act = (grp == 0 || grp == 4);
#pragma unroll
            for (int ai = 0; ai < 2; ++ai)
#pragma unroll
                for (int m = 0; m < 4; ++m)
#pragma unroll
                    for (int bj = 0; bj < 2; ++bj) { f32x4 a = acc[ai][bj][m][0], b = acc[ai][bj][m][1];
                        if (act) { a = (f32x4){silu_f(a[0]), silu_f(a[1]), silu_f(a[2]), silu_f(a[3])}; b = (f32x4){silu_f(b[0]), silu_f(b[1]), silu_f(b[2]), silu_f(b[3])}; }
                        st8(O + (size_t)(row0 + ai * HALF + m * 16) * 1024 + gc0 + bj * HALF, a, b); }
        } else if (grp == 1 || grp == 2) {
            const int d = grp - 1; bf16_t* K = d ? HK1 : HK0; float* L = d ? LF1 : LF0;
#pragma unroll
            for (int bj = 0; bj < 2; ++bj) { const f32x4 l0 = *(const f32x4*)(lb + d * 1024 + gc0 + bj * HALF), l1 = *(const f32x4*)(lb + d * 1024 + gc0 + bj * HALF + 4);
#pragma unroll
                for (int ai = 0; ai < 2; ++ai)
#pragma unroll
                    for (int m = 0; m < 4; ++m) { const f32x4 a = acc[ai][bj][m][0], b = acc[ai][bj][m][1]; f32x4 ka, kb, la, lc;
#pragma unroll
                        for (int e = 0; e < 4; ++e) { const float sa = sigmoid_f(a[e]), sb = sigmoid_f(b[e]);
                            ka[e] = (1.0f - l0[e]) * (1.0f - sa); kb[e] = (1.0f - l1[e]) * (1.0f - sb);
                            la[e] = __logf(l0[e] + (1.0f - l0[e]) * sa); lc[e] = __logf(l1[e] + (1.0f - l1[e]) * sb); }
                        const size_t off = (size_t)(row0 + ai * HALF + m * 16) * 1024 + gc0 + bj * HALF;
                        st8(K + off, ka, kb); *(f32x4*)(L + off) = la; *(f32x4*)(L + off + 4) = lc; } }
        } else {
            bf16_t* O = grp == 5 ? NQ : NK; const float sc = grp == 5 ? 0.08838834764831845f : 1.0f;
            const int head = 2 * (u.pn & 3) + (wc >> 1), half = wc & 1, dcol = head * 128 + 64 * half + 8 * fq; const bool isc = u.pm >= 32;
#pragma unroll
            for (int ai = 0; ai < 2; ++ai)
#pragma unroll
                for (int m = 0; m < 4; ++m) { const int row = row0 + ai * HALF + m * 16; const int pos = half ? (row & 63) : ((row >> 6) & 127);
                    f32x4 c0 = (f32x4){1.f, 1.f, 1.f, 1.f}, c1 = c0, s0 = (f32x4){0.f, 0.f, 0.f, 0.f}, s1 = s0;
                    if (!isc) { const float* ct = ropeT + pos * 32 + 8 * fq; c0 = *(const f32x4*)ct; c1 = *(const f32x4*)(ct + 4); s0 = *(const f32x4*)(ct + 4096); s1 = *(const f32x4*)(ct + 4100); }
                    const f32x4 a0 = acc[ai][0][m][0], a1 = acc[ai][0][m][1], b0 = acc[ai][1][m][0], b1 = acc[ai][1][m][1];
                    bf16_t* p = O + (size_t)row * 1024 + dcol;
                    st8(p, (a0 * c0 - b0 * s0) * sc, (a1 * c1 - b1 * s1) * sc); st8(p + 32, (b0 * c0 + a0 * s0) * sc, (b1 * c1 + a1 * s1) * sc); }
        }
    }
};


struct OrderDown1 {
    StaticOrder S0; int c;
    __device__ void init(int G_, int c_) { S0.init(8192, 2048, G_, c_); c = c_; }
    __device__ bool next(int i, Unit& u) const {
        if (i == 0) return S0.next(0, u);
        if (i == 1 && c < 88) { u.pm = 32; u.pn = c & 7; u.koff = (c >> 3) * 8; u.nt = 8; u.split = 1; return true; }
        return false;
    }
    __device__ __forceinline__ void a_ready(const Unit&) const {}
    __device__ __forceinline__ void done(const Unit&) const {}
};
template <class Epi, class Sched, bool ALIGN_EPI = false, bool SP2 = false>
__device__ __forceinline__ void gemm_phase(PG8_LAS unsigned char* lds, const Gemm g, const Sched& S, const Epi& E) {
    const int tid = threadIdx.x, wid = __builtin_amdgcn_readfirstlane(tid >> 6), lane = tid & 63, wr = wid >> 2, wc = wid & 3, fr = lane & 15, fq = lane >> 4;
    const int K = g.K, nt = K / BK;
    unsigned voffA[2], voffB[2];
#pragma unroll
    for (int i = 0; i < 2; ++i) { int R, C; stage_rc(tid * 16 + i * 8192, R, C); const int Rb = Epi::PERM ? ((R & ~31) + perm32(R & 31)) : R;
        voffA[i] = (unsigned)(R * K + C) * 2u; voffB[i] = (unsigned)(Rb * K + C) * 2u; }
    const size_t kstep = (size_t)(BK * 2);
    const size_t hstep = (size_t)HALF * K * 2;
    const size_t tstep = 2 * hstep;
    const unsigned ldsw = (unsigned)wid * 1024u;
    const int aoff = lds_byte(wr * 64 + fr, fq * 8), boff = lds_byte(wc * 32 + fr, fq * 8);
#define PG8_SA(b, h) (((b) * 2 + (h)) * HTB)
#define PG8_SB(b, h) ((4 + (b) * 2 + (h)) * HTB)
#define PG8_STAGE(bufoff, gbase, voff) do { _Pragma("unroll") for (int _i = 0; _i < 2; ++_i) \
        __builtin_amdgcn_global_load_lds((const unsigned*)((const char*)(gbase) + (voff)[_i]), (PG8_LAS unsigned*)(lds + (bufoff) + ldsw + _i * 8192), 16, 0, 0); } while (0)
#define PG8_LDA(dst, b, h) do { _Pragma("unroll") for (int m = 0; m < 4; ++m) _Pragma("unroll") for (int k = 0; k < 2; ++k) dst[m][k] = *(const PG8_LAS bf16x8*)(lds + PG8_SA(b, h) + aoff + m * 2048 + k * 1024); } while (0)
#define PG8_LDB(dst, b, h) do { _Pragma("unroll") for (int n = 0; n < 2; ++n) _Pragma("unroll") for (int k = 0; k < 2; ++k) dst[n][k] = *(const PG8_LAS bf16x8*)(lds + PG8_SB(b, h) + boff + n * 2048 + k * 1024); } while (0)
#define PG8_MMA(ai, bj, At, Bt) do { __builtin_amdgcn_s_setprio(1); _Pragma("unroll") for (int m = 0; m < 4; ++m) _Pragma("unroll") for (int n = 0; n < 2; ++n) _Pragma("unroll") for (int k = 0; k < 2; ++k) \
        acc[ai][bj][m][n] = __builtin_amdgcn_mfma_f32_16x16x32_bf16(Bt[n][k], At[m][k], acc[ai][bj][m][n], 0, 0, 0); __builtin_amdgcn_s_setprio(0); } while (0)
#define PG8_WAIT_V(n) asm volatile("s_waitcnt vmcnt(" #n ")" ::: "memory")
#define PG8_WAIT_L(n) asm volatile("s_waitcnt lgkmcnt(" #n ")" ::: "memory")
#define PG8_BAR __builtin_amdgcn_s_barrier()
#define PG8_SCHED __builtin_amdgcn_sched_barrier(0)
    Unit cur, nxt; int ui = 0;
    if (!S.next(0, cur)) return;
    f32x4 acc[2][2][4][2];
#pragma unroll
    for (int a = 0; a < 2; ++a)
#pragma unroll
        for (int b = 0; b < 2; ++b)
#pragma unroll
            for (int m = 0; m < 4; ++m)
#pragma unroll
                for (int n = 0; n < 2; ++n) acc[a][b][m][n] = (f32x4){0.f, 0.f, 0.f, 0.f};
    bf16x8 At[4][2], B0[2][2], B1[2][2];
    const char* cA = (const char*)g.A + (size_t)cur.pm * tstep + (size_t)cur.koff * kstep; const char* cB = (const char*)g.Bt + (size_t)cur.pn * tstep + (size_t)cur.koff * kstep;
    S.a_ready(cur);
    if constexpr (SP2) {
        PG8_STAGE(PG8_SB(0, 0), cB, voffB); PG8_STAGE(PG8_SB(0, 1), cB + hstep, voffB); PG8_STAGE(PG8_SA(0, 0), cA, voffA); PG8_STAGE(PG8_SA(0, 1), cA + hstep, voffA);
        if (wr == 1) PG8_BAR;
        PG8_WAIT_V(2); PG8_BAR;
        PG8_STAGE(PG8_SB(1, 0), cB + kstep, voffB); PG8_STAGE(PG8_SA(1, 0), cA + kstep, voffA); PG8_STAGE(PG8_SB(1, 1), cB + hstep + kstep, voffB);
        PG8_WAIT_V(6); PG8_BAR;
    } else {
        PG8_STAGE(PG8_SB(0, 0), cB, voffB); PG8_STAGE(PG8_SA(0, 0), cA, voffA); PG8_STAGE(PG8_SB(0, 1), cB + hstep, voffB); PG8_STAGE(PG8_SA(0, 1), cA + hstep, voffA);
        if (wr == 1) PG8_BAR;
        PG8_WAIT_V(4); PG8_BAR;
        PG8_STAGE(PG8_SB(1, 0), cB + kstep, voffB); PG8_STAGE(PG8_SA(1, 0), cA + kstep, voffA); PG8_STAGE(PG8_SB(1, 1), cB + hstep + kstep, voffB);
        PG8_WAIT_V(6); PG8_BAR;
    }
    for (;;) {
        const bool has_next = S.next(ui + 1, nxt);
        const char* nA = has_next ? (const char*)g.A + (size_t)nxt.pm * tstep + (size_t)nxt.koff * kstep : cA; const char* nB = has_next ? (const char*)g.Bt + (size_t)nxt.pn * tstep + (size_t)nxt.koff * kstep : cB;
        const int unt = cur.nt ? cur.nt : nt;
        for (int t = 0; t < unt; t += 2) {
            const bool last = (t == unt - 2);
            const char* a1 = cA + (size_t)(t + 1) * kstep;
            const char* a2 = last ? nA : cA + (size_t)(t + 2) * kstep; const char* b2 = last ? nB : cB + (size_t)(t + 2) * kstep;
            const char* a3 = a2 + kstep; const char* b3 = b2 + kstep;
            if (last && has_next) S.a_ready(nxt);
            if constexpr (SP2) {
            PG8_LDB(B0, 0, 0); PG8_LDB(B1, 0, 1); PG8_SCHED; PG8_LDA(At, 0, 0); PG8_STAGE(PG8_SA(1, 1), a1 + hstep, voffA);
            PG8_WAIT_V(8); PG8_WAIT_L(0); PG8_BAR; PG8_MMA(0, 0, At, B0); PG8_MMA(0, 1, At, B1); PG8_BAR; PG8_SCHED;
            PG8_LDA(At, 0, 1); PG8_STAGE(PG8_SB(0, 0), b2, voffB); PG8_STAGE(PG8_SB(0, 1), b2 + hstep, voffB); PG8_STAGE(PG8_SA(0, 0), a2, voffA);
            PG8_WAIT_V(8); PG8_WAIT_L(0); PG8_BAR; PG8_MMA(1, 0, At, B0); PG8_MMA(1, 1, At, B1); PG8_BAR; PG8_SCHED;
            PG8_LDB(B0, 1, 0); PG8_LDB(B1, 1, 1); PG8_SCHED; PG8_LDA(At, 1, 0); PG8_STAGE(PG8_SA(0, 1), a2 + hstep, voffA);
            PG8_WAIT_V(8); PG8_WAIT_L(0); PG8_BAR; PG8_MMA(0, 0, At, B0); PG8_MMA(0, 1, At, B1); PG8_BAR; PG8_SCHED;
            PG8_LDA(At, 1, 1); PG8_STAGE(PG8_SB(1, 0), b3, voffB); PG8_STAGE(PG8_SB(1, 1), b3 + hstep, voffB); PG8_STAGE(PG8_SA(1, 0), a3, voffA);
            PG8_WAIT_V(8); PG8_WAIT_L(0); PG8_BAR; PG8_MMA(1, 0, At, B0); PG8_MMA(1, 1, At, B1); PG8_BAR; PG8_SCHED;
            } else {
            PG8_LDB(B0, 0, 0); PG8_SCHED; PG8_LDA(At, 0, 0); PG8_STAGE(PG8_SA(1, 1), a1 + hstep, voffA);
            PG8_WAIT_L(8); PG8_BAR; PG8_WAIT_L(0); PG8_MMA(0, 0, At, B0); PG8_BAR; PG8_SCHED;
            PG8_LDB(B1, 0, 1); PG8_STAGE(PG8_SB(0, 0), b2, voffB);
            PG8_BAR; PG8_WAIT_L(0); PG8_MMA(0, 1, At, B1); PG8_BAR;
            PG8_LDA(At, 0, 1); PG8_STAGE(PG8_SA(0, 0), a2, voffA);
            PG8_BAR; PG8_WAIT_L(0); PG8_MMA(1, 0, At, B0); PG8_BAR; PG8_SCHED;
            PG8_STAGE(PG8_SB(0, 1), b2 + hstep, voffB);
            PG8_WAIT_V(6); PG8_BAR; PG8_MMA(1, 1, At, B1); PG8_BAR;
            PG8_LDB(B0, 1, 0); PG8_SCHED; PG8_LDA(At, 1, 0); PG8_STAGE(PG8_SA(0, 1), a2 + hstep, voffA);
            PG8_WAIT_L(8); PG8_BAR; PG8_WAIT_L(0); PG8_MMA(0, 0, At, B0); PG8_BAR; PG8_SCHED;
            PG8_LDB(B1, 1, 1); PG8_STAGE(PG8_SB(1, 0), b3, voffB);
            PG8_BAR; PG8_WAIT_L(0); PG8_MMA(0, 1, At, B1); PG8_BAR;
            PG8_LDA(At, 1, 1); PG8_STAGE(PG8_SA(1, 0), a3, voffA);
            PG8_BAR; PG8_WAIT_L(0); PG8_MMA(1, 0, At, B0); PG8_BAR; PG8_SCHED;
            PG8_STAGE(PG8_SB(1, 1), b3 + hstep, voffB);
            PG8_WAIT_V(6); PG8_BAR; PG8_MMA(1, 1, At, B1); PG8_BAR;
            }
        }
        if constexpr (ALIGN_EPI) { if (wr == 0) PG8_BAR; }
        if constexpr (!Epi::AFTER_DRAIN) { E(acc, cur, wr, wc, fr, fq); S.done(cur); }
        if (!has_next) break;
#pragma unroll
        for (int a = 0; a < 2; ++a)
#pragma unroll
            for (int b = 0; b < 2; ++b)
#pragma unroll
                for (int m = 0; m < 4; ++m)
#pragma unroll
                    for (int n = 0; n < 2; ++n) acc[a][b][m][n] = (f32x4){0.f, 0.f, 0.f, 0.f};
        cur = nxt; cA = nA; cB = nB; ++ui;
        if constexpr (ALIGN_EPI) { if (wr == 1) PG8_BAR; }
    }
    PG8_WAIT_V(0);
    if constexpr (!ALIGN_EPI) { if (wr == 0) PG8_BAR; }
    PG8_BAR;
    if constexpr (Epi::AFTER_DRAIN) { E.fused(acc, cur, wr, wc, fr, fq, lds, wid, lane); S.done(cur); }
#undef PG8_SA
#undef PG8_SB
#undef PG8_STAGE
#undef PG8_LDA
#undef PG8_LDB
#undef PG8_MMA
#undef PG8_WAIT_V
#undef PG8_WAIT_L
#undef PG8_BAR
#undef PG8_SCHED
}
}
#define GAS __attribute__((address_space(1)))
#define LAS __attribute__((address_space(3)))
typedef unsigned short bf16;
typedef unsigned v4u __attribute__((ext_vector_type(4)));
typedef float f32x4 __attribute__((ext_vector_type(4)));
typedef short bf16x8 __attribute__((ext_vector_type(8)));
typedef GAS unsigned gu32;
typedef GAS unsigned long long gu64;
#define RLX_AGENT __ATOMIC_RELAXED, __HIP_MEMORY_SCOPE_AGENT
#define LDS_WAIT() asm volatile("s_waitcnt lgkmcnt(0)" ::: "memory")
#define VM_WAIT() asm volatile("s_waitcnt vmcnt(0)" ::: "memory")
__device__ __forceinline__ unsigned long long rt() { return __builtin_amdgcn_s_memrealtime(); }
__device__ __forceinline__ unsigned f2bf(float f) { unsigned u = __builtin_bit_cast(unsigned, f); return (u + 0x7fffu + ((u >> 16) & 1u)) >> 16; }
__device__ __forceinline__ unsigned pk2(float lo, float hi) { return f2bf(lo) | (f2bf(hi) << 16); }
#define XB_TMO      128
#define XB_XCNT(j)  (256  + 64 * (j))
#define XB_XSUB(j)  (1280 + 64 * (j))
#define XB_XGEN(j)  (2304 + 64 * (j))
#define XB_TOP      3328
#define XB_TOPGEN   3392
#define XCD_BAR_WORDS 3456
#define XB_SPIN_CAP (1u << 18)

__device__ __forceinline__ unsigned xb_ld(unsigned* p)              { return __hip_atomic_load(p, __ATOMIC_RELAXED, __HIP_MEMORY_SCOPE_AGENT); }
__device__ __forceinline__ unsigned xb_add(unsigned* p, unsigned v) { return __hip_atomic_fetch_add(p, v, __ATOMIC_RELAXED, __HIP_MEMORY_SCOPE_AGENT); }
__device__ __forceinline__ unsigned xb_xcc_id() { return (unsigned)__builtin_amdgcn_s_getreg((3 << 11) | 20) & 0xFu; }
#define XB_SPIN(cond, bar) do { unsigned _sp = 0; while (cond) { __builtin_amdgcn_s_sleep(1); \
    if ((++_sp & 255u) == 0u) { if (xb_ld(&(bar)[XB_TMO])) break; if (_sp > XB_SPIN_CAP) { atomicAdd(&(bar)[XB_TMO], 1u); break; } } } } while (0)

struct XcdBarrier {
    unsigned* bar; unsigned x;
    volatile LAS unsigned* st;
};

__device__ __forceinline__ XcdBarrier xcd_barrier_post(unsigned* bar, volatile LAS unsigned* st) {
    XcdBarrier b; b.bar = bar; b.x = xb_xcc_id(); b.st = st;
    if (threadIdx.x == 0) (void)xb_add(&bar[XB_XCNT(b.x)], 1u);
    return b;
}
__device__ __forceinline__ void xcd_barrier_complete(unsigned* bar, unsigned x, unsigned& nloc, unsigned& nx) {
    const unsigned G = gridDim.x * gridDim.y * gridDim.z;
    unsigned sum, cnt, mine, sp = 0u;
    for (;;) {
        sum = 0u; cnt = 0u; mine = 0u;
#pragma unroll
        for (unsigned j = 0; j < 16; ++j) { const unsigned c = xb_ld(&bar[XB_XCNT(j)]); sum += c; cnt += (c > 0u) ? 1u : 0u; mine = (j == x) ? c : mine; }
        if (sum == G) break;
        __builtin_amdgcn_s_sleep(1);
        if ((++sp & 255u) == 0u) { if (xb_ld(&bar[XB_TMO])) break; if (sp > XB_SPIN_CAP) { atomicAdd(&bar[XB_TMO], 1u); break; } }
    }
    nloc = mine > 0u ? mine : 1u; nx = cnt > 0u ? cnt : 1u;
}

__device__ __forceinline__ void xcd_barrier(const XcdBarrier& b) {
    asm volatile("s_waitcnt vmcnt(0)" ::: "memory");
    __syncthreads();
    if (threadIdx.x == 0) {
        unsigned* bar = b.bar;
        __builtin_amdgcn_s_waitcnt(0);
        unsigned nloc = b.st[0], nx = b.st[1];
        if (nloc == 0u) { xcd_barrier_complete(bar, b.x, nloc, nx); b.st[0] = nloc; b.st[1] = nx; }
        const unsigned old = xb_add(&bar[XB_XSUB(b.x)], 1u);
        const unsigned gen = old / nloc;
        if (old + 1u == (gen + 1u) * nloc) {
            __builtin_amdgcn_fence(__ATOMIC_RELEASE, "agent");
            asm volatile("s_waitcnt vmcnt(0)" ::: "memory");
            const unsigned og = xb_add(&bar[XB_TOP], 1u);
            const unsigned tg = og / nx;
            if (og + 1u == (tg + 1u) * nx) xb_add(&bar[XB_TOPGEN], 1u);
            else XB_SPIN(xb_ld(&bar[XB_TOPGEN]) == tg, bar);
            __builtin_amdgcn_fence(__ATOMIC_ACQUIRE, "agent");
            xb_add(&bar[XB_XGEN(b.x)], 1u);
            asm volatile("s_waitcnt vmcnt(0)" ::: "memory");
        } else {
            XB_SPIN(xb_ld(&bar[XB_XGEN(b.x)]) == gen, bar);
            __builtin_amdgcn_fence(__ATOMIC_ACQUIRE, "agent");
            asm volatile("s_waitcnt vmcnt(0)" ::: "memory");
        }
    }
    __syncthreads();
}
typedef float f32x2v __attribute__((ext_vector_type(2)));
constexpr int NWAVES = 8;
constexpr int D = 2048, T = 8192, CTX = 256, MT = T + CTX, FF = 5632, INC = 8192, HW = 1024, NMOD = 9;
constexpr float EPS = 1e-6f;
constexpr int N_PHASES = 15;
#ifndef MK_N_LAUNCHES
#define MK_N_LAUNCHES 1
#endif

constexpr size_t MiB = 1u << 20;
constexpr size_t WS_CTL = 0, CTL_ZERO_BYTES = 1 * MiB;
constexpr size_t WS_MOD = 256 * 1024;
constexpr size_t WS_TAB = 1 * MiB;
constexpr size_t WS_W1 = 2 * MiB, WS_WD1 = 46 * MiB, WS_WIN = 68 * MiB, WS_WOUT = 100 * MiB, WS_W2 = 108 * MiB, WS_WD2 = 152 * MiB;
constexpr size_t WS_U = 174 * MiB;
constexpr size_t WS_HC = 207 * MiB;
constexpr size_t WS_P = 209 * MiB;
constexpr size_t P_BF = (size_t)MT * HW * 2, P_F32 = (size_t)MT * HW * 4;
constexpr size_t WS_HQ = WS_P, WS_HK0 = WS_HQ + P_BF, WS_HK1 = WS_HK0 + P_BF, WS_HV = WS_HK1 + P_BF, WS_HG = WS_HV + P_BF, WS_NQ = WS_HG + P_BF, WS_NK = WS_NQ + P_BF, WS_NV = WS_NK + P_BF,
                 WS_LF0 = WS_NV + P_BF, WS_LF1 = WS_LF0 + P_F32, WS_PEND = WS_LF1 + P_F32;
constexpr size_t WS_HID = WS_P;
constexpr size_t WS_MX = 408 * MiB;
constexpr size_t WS_END = WS_MX + 97 * MiB;
constexpr size_t WS_SLAB = WS_MX;
static_assert(WS_PEND <= WS_MX && WS_HID + (size_t)MT * FF * 2 <= WS_MX && WS_U + (size_t)MT * D * 2 <= WS_HC && WS_WD2 + (size_t)D * FF * 2 <= WS_U, "d_ws map");
constexpr int CW_BAR = 4096;

constexpr int RING_OFF = 0, SCR_BYTES = 139264;
constexpr int MISC_OFF = SCR_BYTES;
constexpr int LDS_BYTES = 147456;

struct Frame {
    LAS unsigned char* lds;
    volatile LAS unsigned* MISC;
    gu32* ctl;
    int tid, lane, wave, vcu, G;
    const float* in[19]; float* out; unsigned char* ws;
};
__device__ __forceinline__ float wave_sum(float v) {
#pragma unroll
    for (int o = 1; o < 64; o <<= 1) v += __shfl_xor(v, o);
    return v;
}
__device__ __forceinline__ float wave_max(float v) {
#pragma unroll
    for (int o = 1; o < 64; o <<= 1) v = fmaxf(v, __shfl_xor(v, o));
    return v;
}
__device__ __forceinline__ float bf2f(unsigned short b) { return __builtin_bit_cast(float, (unsigned)b << 16); }
__device__ __forceinline__ float bflo(unsigned w) { return __builtin_bit_cast(float, w << 16); }
__device__ __forceinline__ float bfhi(unsigned w) { return __builtin_bit_cast(float, w & 0xffff0000u); }
__device__ __forceinline__ float silu_d(float v) { return v / (1.0f + __expf(-v)); }

__device__ __forceinline__ int dst_row(int kind, int n) {
    if (kind == 0) return n;
    if (kind == 1) return 256 * (n >> 7) + (n & 127);
    if (kind == 2) return 256 * (n >> 7) + 128 + (n & 127);
    const int grp = n >> 10;
    if (grp != 5 && grp != 6) return n;
    const int head = (n & 1023) >> 7, dim = n & 127, half = dim >> 6, bj = (dim & 63) >> 5, i = dim & 31;
    return grp * 1024 + 256 * (head >> 1) + 128 * bj + 32 * (2 * (head & 1) + half) + i;
}
struct ConvSrc { const float* W; bf16* WT; int K, N, kind, k0, n0; };
__device__ __forceinline__ void conv_load(const ConvSrc& c, int lane, f32x4 (&v)[16]) {
    const GAS f32x4* src = (const GAS f32x4*)(c.W + (size_t)(c.k0 + (lane >> 4)) * c.N + c.n0 + 4 * (lane & 15));
#pragma unroll
    for (int i = 0; i < 16; ++i) v[i] = src[(size_t)i * c.N];
}
__device__ __forceinline__ void conv_store(const ConvSrc& c, int lane, const f32x4 (&v)[16], LAS float* scr) {
#pragma unroll
    for (int i = 0; i < 16; ++i) { LAS float* d = scr + (4 * (lane & 15)) * 65 + (lane >> 4) + 4 * i;
        d[0] = v[i].x; d[65] = v[i].y; d[130] = v[i].z; d[195] = v[i].w; }
    LDS_WAIT(); asm volatile("" ::: "memory");
#pragma unroll
    for (int i = 0; i < 8; ++i) { const int n = (lane >> 3) + 8 * i; const LAS float* sp = scr + n * 65 + 8 * (lane & 7);
        v4u o; o.x = pk2(sp[0], sp[1]); o.y = pk2(sp[2], sp[3]); o.z = pk2(sp[4], sp[5]); o.w = pk2(sp[6], sp[7]);
        *(GAS v4u*)(c.WT + (size_t)dst_row(c.kind, c.n0 + n) * c.K + c.k0 + 8 * (lane & 7)) = o; }
    LDS_WAIT(); asm volatile("" ::: "memory");
}
constexpr int CI_GU = (D / 64) * (FF / 64), CI_IN = (D / 64) * (INC / 64), CI_OUT = (D / 64) * (D / 64);
constexpr int CI_W1 = 0, CI_WD1 = 2 * CI_GU, CI_WIN = 3 * CI_GU, CI_WOUT = CI_WIN + CI_IN, CI_W2 = CI_WOUT + CI_OUT, CI_WD2 = CI_W2 + 2 * CI_GU, CI_END = CI_WD2 + CI_GU;
__device__ __forceinline__ ConvSrc conv_desc(Frame& F, int it) {
    unsigned char* ws = F.ws; ConvSrc c; int r = it;
    if (r < CI_GU) { c.W = F.in[7]; c.WT = (bf16*)(ws + WS_W1); c.K = D; c.N = FF; c.kind = 1; }
    else if ((r -= CI_GU) < CI_GU) { c.W = F.in[8]; c.WT = (bf16*)(ws + WS_W1); c.K = D; c.N = FF; c.kind = 2; }
    else if ((r -= CI_GU) < CI_GU) { c.W = F.in[9]; c.WT = (bf16*)(ws + WS_WD1); c.K = FF; c.N = D; c.kind = 0; }
    else if ((r -= CI_GU) < CI_IN) { c.W = F.in[10]; c.WT = (bf16*)(ws + WS_WIN); c.K = D; c.N = INC; c.kind = 3; }
    else if ((r -= CI_IN) < CI_OUT) { c.W = F.in[14]; c.WT = (bf16*)(ws + WS_WOUT); c.K = D; c.N = D; c.kind = 0; }
    else if ((r -= CI_OUT) < CI_GU) { c.W = F.in[15]; c.WT = (bf16*)(ws + WS_W2); c.K = D; c.N = FF; c.kind = 1; }
    else if ((r -= CI_GU) < CI_GU) { c.W = F.in[16]; c.WT = (bf16*)(ws + WS_W2); c.K = D; c.N = FF; c.kind = 2; }
    else { r -= CI_GU; c.W = F.in[17]; c.WT = (bf16*)(ws + WS_WD2); c.K = FF; c.N = D; c.kind = 0; }
    const int nblk = c.N >> 6, kb = r / nblk; c.k0 = 64 * kb; c.n0 = 64 * (r - kb * nblk);
    return c;
}
__device__ __forceinline__ void conv_range(Frame& F, int first, int count, int worker, int nworkers) {
    LAS float* scr = (LAS float*)(F.lds + RING_OFF + F.wave * 17408); const int lane = F.lane;
    int it = first + worker; if (it >= first + count) return;
    ConvSrc cur = conv_desc(F, it); f32x4 va[16], vb[16];
    conv_load(cur, lane, va);
    for (;;) {
        const int nx = it + nworkers; const bool more = nx < first + count;
        ConvSrc nxt = cur; if (more) { nxt = conv_desc(F, nx); conv_load(nxt, lane, vb); }
        conv_store(cur, lane, va, scr);
        if (!more) break;
#pragma unroll
        for (int i = 0; i < 16; ++i) va[i] = vb[i];
        cur = nxt; it = nx;
    }
}
__device__ __forceinline__ void conv_tail(Frame& F, int first_idle, int first, int count) {
    const int c = (int)blockIdx.x; if (c < first_idle) return;
    conv_range(F, first, count, (c - first_idle) * NWAVES + F.wave, (F.G - first_idle) * NWAVES);
}
__device__ __forceinline__ void p0_prologue(Frame& F) {
    LAS float* scr = (LAS float*)(F.lds + RING_OFF + F.wave * 17408);
    const int gw = F.vcu * NWAVES + F.wave, NGW = F.G * NWAVES, lane = F.lane;
    unsigned char* ws = F.ws;
    float* tab = (float*)(ws + WS_TAB);
    for (int i = gw * 64 + lane; i < 4096; i += NGW * 64) { const int pos = i >> 5, fi = i & 31; const float inv = powf(10000.0f, -(float)fi / 32.0f); const float ang = (float)pos * inv; tab[i] = cosf(ang); tab[4096 + i] = sinf(ang); }
    for (int i = gw * 64 + lane; i < 2048; i += NGW * 64) { const int d = i >> 10, c = i & 1023; const float* lg = F.in[11] + d * 2048 + c; const float a = lg[0], b = lg[1024]; tab[16384 + i] = 1.0f / (1.0f + expf(b - a)); }
    {
        const float* wm = F.in[4]; float* mod = (float*)(ws + WS_MOD);
        for (int it = gw; it < 64 * 72; it += NGW) {
            const int kb = it / 72, cb = it - kb * 72, k0 = 32 * kb, col = 256 * cb + 4 * lane;
            const float sl = silu_d(F.in[1][k0 + (lane & 31)]), sc = silu_d(F.in[3][k0 + (lane & 31)]);
            f32x4 al = (f32x4){0.f, 0.f, 0.f, 0.f}, ac = al;
            if (kb == 0) { al = *(const GAS f32x4*)(F.in[5] + col); ac = al; }
            const GAS f32x4* wp = (const GAS f32x4*)(wm + (size_t)k0 * (NMOD * D) + col);
#pragma unroll 8
            for (int kk = 0; kk < 32; ++kk) { const f32x4 w = wp[(size_t)kk * (NMOD * D / 4)]; const float a = __shfl(sl, kk), b = __shfl(sc, kk); al += w * a; ac += w * b; }
#pragma unroll
            for (int e = 0; e < 4; ++e) { atomicAdd(mod + col + e, al[e]); atomicAdd(mod + NMOD * D + col + e, ac[e]); }
        }
    }
    conv_range(F, 0, 2 * CI_GU, gw, NGW);
}
template <bool SLABS>
__device__ __forceinline__ void norm_mod_phase(Frame& F, const float* src_l, const float* src_c, int nrows, int nwj, int shj, int scj) {
    const int gw = F.vcu * NWAVES + F.wave, NGW = F.G * NWAVES;
    const float* mod = (const float*)(F.ws + WS_MOD); bf16* U = (bf16*)(F.ws + WS_U);
    for (int row = gw; row < nrows; row += NGW) {
        const bool isc = row >= T; const float* hr = isc ? src_c + (size_t)(row - T) * D : src_l + (size_t)row * D; const float* mv = mod + (isc ? NMOD * D : 0);
        const GAS f32x4* xr = (const GAS f32x4*)hr + F.lane;
        f32x4 v[8]; float s = 0.f;
#pragma unroll
        for (int j = 0; j < 8; ++j) v[j] = xr[64 * j];
        if (SLABS && isc) {
            const GAS f32x4* sl = (const GAS f32x4*)((const float*)(F.ws + WS_SLAB) + (size_t)(row - T) * D) + F.lane;
#pragma unroll
            for (int j = 0; j < 8; ++j) { f32x4 a = sl[64 * j];
#pragma unroll
                for (int k = 1; k < 11; ++k) a += sl[(size_t)k * (256 * 2048 / 4) + 64 * j];
                const f32x4 gt = *(const GAS f32x4*)(mv + 2 * D + 4 * F.lane + 256 * j); v[j] += a * gt * 0.5f; asm volatile("" ::: "memory"); }
        }
#pragma unroll
        for (int j = 0; j < 8; ++j) s += (v[j].x * v[j].x + v[j].y * v[j].y) + (v[j].z * v[j].z + v[j].w * v[j].w);
        const float rs = 1.0f / sqrtf(wave_sum(s) * (1.0f / D) + EPS);
        GAS unsigned long long* o8 = (GAS unsigned long long*)(U + (size_t)row * D) + F.lane;
#pragma unroll
        for (int j = 0; j < 8; ++j) { const int col = 4 * F.lane + 256 * j;
            const f32x4 nw = *(const GAS f32x4*)(F.in[6] + nwj * D + col), sc = *(const GAS f32x4*)(mv + scj * D + col), sh = *(const GAS f32x4*)(mv + shj * D + col);
            const f32x4 o = v[j] * rs * nw * (sc + 1.0f) + sh;
            o8[64 * j] = (unsigned long long)pk2(o.x, o.y) | ((unsigned long long)pk2(o.z, o.w) << 32); }
    }
}
__device__ __forceinline__ void final_norm_phase(Frame& F) {
    const int gw = F.vcu * NWAVES + F.wave, NGW = F.G * NWAVES;
    for (int row = gw; row < T; row += NGW) {
        GAS f32x4* xr = (GAS f32x4*)(F.out + (size_t)row * D) + F.lane;
        f32x4 v[8]; float s = 0.f;
#pragma unroll
        for (int j = 0; j < 8; ++j) { v[j] = xr[64 * j]; s += (v[j].x * v[j].x + v[j].y * v[j].y) + (v[j].z * v[j].z + v[j].w * v[j].w); }
        const float rs = 1.0f / sqrtf(wave_sum(s) * (1.0f / D) + EPS);
#pragma unroll
        for (int j = 0; j < 8; ++j) { const f32x4 fw = *(const GAS f32x4*)(F.in[18] + 4 * F.lane + 256 * j); xr[64 * j] = v[j] * rs * fw; }
    }
}
typedef short s16x4 __attribute__((ext_vector_type(4)));
__device__ __forceinline__ s16x4 lds_tr(const LAS unsigned char* p) { return __builtin_amdgcn_ds_read_tr16_b64_v4i16((LAS s16x4*)p); }
__device__ __forceinline__ f32x4 mfma16(bf16x8 a, bf16x8 b, f32x4 c) { return __builtin_amdgcn_mfma_f32_16x16x32_bf16(a, b, c, 0, 0, 0); }
constexpr int HG_QH = 0, HG_KT = 16384, HG_KTT = 32768, HG_VN = 49152, HG_SP = 65536, HG_PM = 98304, HG_DEC = 106496, HG_CS = 107520;
constexpr size_t WS_OF = WS_MX, WS_ST = WS_MX + 64 * MiB, WS_DT = WS_ST + 32 * MiB;
template <bool FULL>
__device__ __forceinline__ void hg_chunk(Frame& F, int hd, int c) {
    const int tid = F.tid, lane = F.lane, w = F.wave, n = lane & 15, g = lane >> 4, head = hd >> 1, dir = hd & 1;
    unsigned char* ws = F.ws; LAS unsigned char* L = F.lds;
    const bf16* HQ = (const bf16*)(ws + WS_HQ); const bf16* HK = (const bf16*)(ws + (dir ? WS_HK1 : WS_HK0)); const float* LF = (const float*)(ws + (dir ? WS_LF1 : WS_LF0)); const bf16* HV = (const bf16*)(ws + WS_HV);
    float* OF = (float*)(ws + WS_OF) + (size_t)dir * T * HW; float* ST = (float*)(ws + WS_ST); float* DT = (float*)(ws + WS_DT);
    const int tc = dir ? 32 - c : c - 1, row0 = c == 0 ? T : 256 * tc;
    f32x4 sacc[8];
    if (FULL) { const float* sp = ST + ((size_t)(hd * 32 + (c - 1)) * 128) * 128 + 16 * w + n;
#pragma unroll
        for (int dt = 0; dt < 8; ++dt)
#pragma unroll
            for (int i = 0; i < 4; ++i) sacc[dt][i] = sp[(size_t)(16 * dt + 4 * g + i) * 128]; }
    else {
#pragma unroll
        for (int dt = 0; dt < 8; ++dt) sacc[dt] = (f32x4){0.f, 0.f, 0.f, 0.f}; }
    float dtot0 = 0.f, dtot1 = 0.f;
    const int dp = lane, tg = w;
    for (int jj = 0; jj < 4; ++jj) {
        const int j = dir ? 3 - jj : jj, r0 = row0 + 64 * j;
        float lf0[8], lf1[8]; unsigned q2[8], k2[8];
#pragma unroll
        for (int e = 0; e < 8; ++e) { const size_t o = (size_t)(r0 + 8 * tg + e) * HW + head * 128 + 2 * dp;
            const f32x2v t = *(const GAS f32x2v*)(LF + o); lf0[e] = t.x; lf1[e] = t.y; k2[e] = *(const GAS unsigned*)(HK + o); if (FULL) q2[e] = *(const GAS unsigned*)(HQ + o); }
        v4u vreg[2];
#pragma unroll
        for (int p = 0; p < 2; ++p) { const int ch = tid + 512 * p; vreg[p] = *(const GAS v4u*)(HV + (size_t)(r0 + (ch >> 4)) * HW + head * 128 + (ch & 15) * 8); }
        float b0[8], b1[8]; float run0 = 0.f, run1 = 0.f;
        if (dir == 0) {
#pragma unroll
            for (int e = 0; e < 8; ++e) { run0 += lf0[e]; run1 += lf1[e]; b0[e] = run0; b1[e] = run1; } }
        else {
#pragma unroll
            for (int e = 7; e >= 0; --e) { run0 += lf0[e]; run1 += lf1[e]; b0[e] = run0; b1[e] = run1; } }
        __syncthreads();
        *(LAS f32x2v*)(L + HG_CS + (tg * 128 + 2 * dp) * 4) = (f32x2v){run0, run1};
        __syncthreads();
        float off0 = 0.f, off1 = 0.f, mid0 = 0.f, mid1 = 0.f, bc0 = 0.f, bc1 = 0.f;
#pragma unroll
        for (int x = 0; x < 8; ++x) { const f32x2v t = *(const LAS f32x2v*)(L + HG_CS + (x * 128 + 2 * dp) * 4);
            const bool inoff = dir ? (x > tg) : (x < tg), inmid = dir ? (x >= 4) : (x < 4);
            off0 += inoff ? t.x : 0.f; off1 += inoff ? t.y : 0.f; mid0 += inmid ? t.x : 0.f; mid1 += inmid ? t.y : 0.f; bc0 += t.x; bc1 += t.y; }
        unsigned kt[8];
#pragma unroll
        for (int e = 0; e < 8; ++e) { const float bb0 = b0[e] + off0, bb1 = b1[e] + off1; const int tau = 8 * tg + e;
            const float ek0 = __expf(fminf(mid0 - bb0, 60.f)), ek1 = __expf(fminf(mid1 - bb1, 60.f));
            kt[e] = pk2(bflo(k2[e]) * ek0, bfhi(k2[e]) * ek1);
            if (FULL) { const float eq0 = __expf(fminf(bb0 - mid0, 60.f)), eq1 = __expf(fminf(bb1 - mid1, 60.f));
                const int bo = tau * 256 + (((dp >> 2) ^ (tau & 15)) << 4) + (dp & 3) * 4;
                *(LAS unsigned*)(L + HG_QH + bo) = pk2(bflo(q2[e]) * eq0, bfhi(q2[e]) * eq1); *(LAS unsigned*)(L + HG_KT + bo) = kt[e]; } }
        {
            v4u lo, hi;
            lo.x = (kt[0] & 0xffffu) | (kt[1] << 16); lo.y = (kt[2] & 0xffffu) | (kt[3] << 16); lo.z = (kt[4] & 0xffffu) | (kt[5] << 16); lo.w = (kt[6] & 0xffffu) | (kt[7] << 16);
            hi.x = (kt[0] >> 16) | (kt[1] & 0xffff0000u); hi.y = (kt[2] >> 16) | (kt[3] & 0xffff0000u); hi.z = (kt[4] >> 16) | (kt[5] & 0xffff0000u); hi.w = (kt[6] >> 16) | (kt[7] & 0xffff0000u);
            const int d0 = 2 * dp; const int sw = (tg ^ (dp & 7)) << 4;
            *(LAS v4u*)(L + HG_KTT + d0 * 128 + sw) = lo; *(LAS v4u*)(L + HG_KTT + (d0 + 1) * 128 + sw) = hi; }
        if (tg == 0) { *(LAS f32x2v*)(L + HG_DEC + 2 * dp * 4) = (f32x2v){__expf(mid0), __expf(mid1)}; *(LAS f32x2v*)(L + HG_DEC + 512 + 2 * dp * 4) = (f32x2v){__expf(bc0 - mid0), __expf(bc1 - mid1)}; }
        dtot0 += bc0; dtot1 += bc1;
#pragma unroll
        for (int p = 0; p < 2; ++p) { const int ch = tid + 512 * p, row = ch >> 4, cc = ch & 15, fr_ = (row & 3) | ((row >> 1) & 4);
            *(LAS v4u*)(L + HG_VN + row * 256 + ((((cc >> 1) ^ fr_) << 5) | ((cc & 1) << 4))) = vreg[p]; }
        __syncthreads();
#pragma unroll
        for (int dt = 0; dt < 8; ++dt) { const f32x4 dm = *(const LAS f32x4*)(L + HG_DEC + (16 * dt + 4 * g) * 4); sacc[dt] *= dm; }
        if (FULL) {
            const int v = 16 * w + n;
#pragma unroll
            for (int dt = 0; dt < 8; ++dt) { const unsigned long long pk = (unsigned long long)pk2(sacc[dt][0], sacc[dt][1]) | ((unsigned long long)pk2(sacc[dt][2], sacc[dt][3]) << 32);
                *(LAS unsigned long long*)(L + HG_SP + v * 256 + (((2 * dt + (g >> 1)) ^ (v & 15)) << 4) + 8 * (g & 1)) = pk; }
#pragma unroll
            for (int x = 0; x < 2; ++x) { const int id = 2 * w + x, tt = id >> 2, st = id & 3; const int rs_ = 16 * st + n, rt_ = 16 * tt + n;
                f32x4 a = (f32x4){0.f, 0.f, 0.f, 0.f};
#pragma unroll
                for (int kk = 0; kk < 4; ++kk) { const bf16x8 kf = *(const LAS bf16x8*)(L + HG_KT + rs_ * 256 + (((g + 4 * kk) ^ (rs_ & 15)) << 4)), qf = *(const LAS bf16x8*)(L + HG_QH + rt_ * 256 + (((g + 4 * kk) ^ (rt_ & 15)) << 4));
                    a = mfma16(kf, qf, a); }
                const int tau = 16 * tt + n, s0 = 16 * st + 4 * g;
#pragma unroll
                for (int i = 0; i < 4; ++i) { const bool keep = dir ? (s0 + i >= tau) : (s0 + i <= tau); a[i] = keep ? a[i] : 0.f; }
                const unsigned long long pk = (unsigned long long)pk2(a[0], a[1]) | ((unsigned long long)pk2(a[2], a[3]) << 32);
                *(LAS unsigned long long*)(L + HG_PM + tau * 128 + (((2 * st + (g >> 1)) ^ ((tau >> 1) & 7)) << 4) + 8 * (g & 1)) = pk; }
            __syncthreads();
        }
        bf16x8 vf[2];
#pragma unroll
        for (int kp = 0; kp < 2; ++kp) { const int ra = 32 * kp + 8 * g + (n >> 2), rb = ra + 4; const int fa = (ra & 3) | ((ra >> 1) & 4), fb = (rb & 3) | ((rb >> 1) & 4);
            const s16x4 ta = lds_tr(L + HG_VN + ra * 256 + ((w ^ fa) << 5) + 8 * (n & 3)), tb = lds_tr(L + HG_VN + rb * 256 + ((w ^ fb) << 5) + 8 * (n & 3));
            vf[kp] = (bf16x8){ta[0], ta[1], ta[2], ta[3], tb[0], tb[1], tb[2], tb[3]}; }
        if (FULL) {
            const int v = 16 * w + n; bf16x8 spf[4];
#pragma unroll
            for (int kk = 0; kk < 4; ++kk) spf[kk] = *(const LAS bf16x8*)(L + HG_SP + v * 256 + (((g + 4 * kk) ^ (v & 15)) << 4));
#pragma unroll
            for (int tt = 0; tt < 4; ++tt) { const int tau = 16 * tt + n; f32x4 o = (f32x4){0.f, 0.f, 0.f, 0.f};
#pragma unroll
                for (int kp = 0; kp < 2; ++kp) { const bf16x8 pf = *(const LAS bf16x8*)(L + HG_PM + tau * 128 + (((g + 4 * kp) ^ ((tau >> 1) & 7)) << 4)); o = mfma16(pf, vf[kp], o); }
#pragma unroll
                for (int kk = 0; kk < 4; ++kk) { const bf16x8 qf = *(const LAS bf16x8*)(L + HG_QH + tau * 256 + (((g + 4 * kk) ^ (tau & 15)) << 4)); o = mfma16(qf, spf[kk], o); }
                float* op = OF + (size_t)(r0 + 16 * tt + 4 * g) * HW + head * 128 + 16 * w + n;
#pragma unroll
                for (int i = 0; i < 4; ++i) op[(size_t)i * HW] = o[i]; }
        }
#pragma unroll
        for (int dt = 0; dt < 8; ++dt) { const int d = 16 * dt + n;
#pragma unroll
            for (int kp = 0; kp < 2; ++kp) { const bf16x8 kf = *(const LAS bf16x8*)(L + HG_KTT + d * 128 + (((g + 4 * kp) ^ ((d >> 1) & 7)) << 4)); sacc[dt] = mfma16(kf, vf[kp], sacc[dt]); }
            const f32x4 de = *(const LAS f32x4*)(L + HG_DEC + 512 + (16 * dt + 4 * g) * 4); sacc[dt] *= de; }
    }
    if (!FULL) { float* sp = ST + ((size_t)(hd * 32 + c) * 128) * 128 + 16 * w + n;
#pragma unroll
        for (int dt = 0; dt < 8; ++dt)
#pragma unroll
            for (int i = 0; i < 4; ++i) sp[(size_t)(16 * dt + 4 * g + i) * 128] = sacc[dt][i];
        if (tg == 0) *(GAS f32x2v*)(DT + (size_t)(hd * 32 + c) * 128 + 2 * dp) = (f32x2v){__expf(dtot0), __expf(dtot1)}; }
}
__device__ __forceinline__ void hg_scan(Frame& F) {
    float* ST = (float*)(F.ws + WS_ST); const float* DT = (const float*)(F.ws + WS_DT);
    for (int gid = F.vcu * (NWAVES * 64) + F.tid; gid < 16 * 128 * 64; gid += F.G * NWAVES * 64) {
        const int hd = gid >> 13, d = (gid >> 6) & 127, v2 = gid & 63;
        GAS f32x2v* sp = (GAS f32x2v*)(ST + ((size_t)(hd * 32) * 128 + d) * 128) + v2; const float* dp_ = DT + (size_t)hd * 32 * 128 + d;
        f32x2v S = (f32x2v){0.f, 0.f};
#pragma unroll 8
        for (int c = 0; c < 32; ++c) { const f32x2v l = sp[(size_t)c * 8192]; const float dc = dp_[c * 128]; S = S * dc + l; sp[(size_t)c * 8192] = S; }
    }
}
__device__ __forceinline__ void na_phase(Frame& F, int first, int stride) {
    const int tid = F.tid, lane = F.lane, wave = F.wave, n = lane & 15, g = lane >> 4, hh = wave >> 2, a = wave & 3;
    unsigned char* ws = F.ws; LAS unsigned char* L = F.lds;
    const bf16* NQ = (const bf16*)(ws + WS_NQ); const bf16* NK = (const bf16*)(ws + WS_NK); const bf16* NV = (const bf16*)(ws + WS_NV); bf16* MIX = (bf16*)(ws + WS_U);
    LAS float* rp = (LAS float*)(L + 131072);
    const unsigned wmask = a == 0 ? 3u : (a == 1 ? 7u : (a == 2 ? 14u : 12u));
    for (int it = first; it < 512; it += stride) {
        const int r = it >> 2, hp = it & 3, h = 2 * hp + hh, rs = min(max(r - 4, 0), 120), t0 = r * 64, cq = 16 * a + n, cs = min(max(cq - 8, 0), 48);
        __syncthreads();
        for (int i = tid; i < 930; i += NWAVES * 64) rp[i] = F.in[13][(2 * hp) * 465 + i];
        bf16x8 qf[4];
        { const bf16* qp = NQ + (size_t)(t0 + 16 * a + n) * HW + h * 128 + 8 * g;
#pragma unroll
          for (int kk = 0; kk < 4; ++kk) qf[kk] = *(const GAS bf16x8*)(qp + 32 * kk); }
        v4u kreg[4], vreg[4];
#define NA_LOAD(t) do { const int tok0_ = (t) < 8 ? (rs + (t)) * 64 : T + ((t) - 8) * 64; \
        _Pragma("unroll") for (int p_ = 0; p_ < 4; ++p_) { const int ch_ = tid + 512 * p_; const size_t go_ = (size_t)(tok0_ + (ch_ >> 5)) * HW + hp * 256 + (ch_ & 31) * 8; \
            kreg[p_] = *(const GAS v4u*)(NK + go_); vreg[p_] = *(const GAS v4u*)(NV + go_); } } while (0)
#define NA_STORE(b) do { _Pragma("unroll") for (int p_ = 0; p_ < 4; ++p_) { const int ch_ = tid + 512 * p_, row_ = ch_ >> 5, hd_ = (ch_ >> 4) & 1, c_ = ch_ & 15; \
            *(LAS v4u*)(L + (b) * 32768 + hd_ * 16384 + row_ * 256 + ((c_ ^ (row_ & 15)) << 4)) = kreg[p_]; \
            *(LAS v4u*)(L + 65536 + (b) * 32768 + hd_ * 16384 + row_ * 256 + ((((c_ >> 1) ^ (row_ & 7)) << 5) | ((c_ & 1) << 4))) = vreg[p_]; } } while (0)
        NA_LOAD(0); NA_STORE(0);
        __syncthreads();
        float m = -1e30f, l = 0.f; f32x4 o[8];
#pragma unroll
        for (int vs = 0; vs < 8; ++vs) o[vs] = (f32x4){0.f, 0.f, 0.f, 0.f};
        for (int t = 0; t < 12; ++t) {
            if (t + 1 < 12) NA_LOAD(t + 1);
            const int b = t & 1; const bool win = t < 8; const unsigned mask = win ? wmask : 15u;
            const LAS unsigned char* Kb = L + b * 32768 + hh * 16384; const LAS unsigned char* Vb = L + 65536 + b * 32768 + hh * 16384;
            f32x4 s[4];
#pragma unroll
            for (int ks = 0; ks < 4; ++ks) {
                s[ks] = (f32x4){0.f, 0.f, 0.f, 0.f};
                if ((mask >> ks) & 1u) {
                    const int row = 16 * ks + n;
#pragma unroll
                    for (int kk = 0; kk < 4; ++kk) { const bf16x8 kf = *(const LAS bf16x8*)(Kb + row * 256 + (((g + 4 * kk) ^ (row & 15)) << 4)); s[ks] = mfma16(kf, qf[kk], s[ks]); }
                }
            }
            float mx = -1e30f;
            const LAS float* rpr = rp + hh * 465 + (rs + t - r + 7) * 31 + 15 - cq;
#pragma unroll
            for (int ks = 0; ks < 4; ++ks)
#pragma unroll
                for (int i = 0; i < 4; ++i) { const int ck = 16 * ks + 4 * g + i; float v = s[ks][i];
                    if (win) { const bool ok = ((mask >> ks) & 1u) && ck >= cs && ck < cs + 16; v = ok ? v + rpr[ok ? ck : cq] : -1e30f; }
                    s[ks][i] = v; mx = fmaxf(mx, v); }
            mx = fmaxf(mx, __shfl_xor(mx, 16)); mx = fmaxf(mx, __shfl_xor(mx, 32));
            const float mn = fmaxf(m, mx), alpha = __expf(m - mn); m = mn;
            float rsum = 0.f;
#pragma unroll
            for (int ks = 0; ks < 4; ++ks)
#pragma unroll
                for (int i = 0; i < 4; ++i) { const float p = __expf(s[ks][i] - mn); s[ks][i] = p; rsum += p; }
            rsum += __shfl_xor(rsum, 16); rsum += __shfl_xor(rsum, 32);
            l = l * alpha + rsum;
#pragma unroll
            for (int vs = 0; vs < 8; ++vs) o[vs] *= alpha;
#pragma unroll
            for (int kp = 0; kp < 2; ++kp) {
                if ((mask >> (2 * kp)) & 3u) {
                    bf16x8 pf; { const unsigned w0 = pk2(s[2 * kp][0], s[2 * kp][1]), w1 = pk2(s[2 * kp][2], s[2 * kp][3]), w2 = pk2(s[2 * kp + 1][0], s[2 * kp + 1][1]), w3 = pk2(s[2 * kp + 1][2], s[2 * kp + 1][3]);
                        const v4u w = (v4u){w0, w1, w2, w3}; pf = __builtin_bit_cast(bf16x8, w); }
                    const int rowA = 32 * kp + 4 * g + (n >> 2);
#pragma unroll
                    for (int vs = 0; vs < 8; ++vs) {
                        const s16x4 ta = lds_tr(Vb + rowA * 256 + ((vs ^ (rowA & 7)) << 5) + 8 * (n & 3));
                        const s16x4 tb = lds_tr(Vb + (rowA + 16) * 256 + ((vs ^ (rowA & 7)) << 5) + 8 * (n & 3));
                        const bf16x8 vf = (bf16x8){ta[0], ta[1], ta[2], ta[3], tb[0], tb[1], tb[2], tb[3]};
                        o[vs] = mfma16(vf, pf, o[vs]);
                    }
                }
            }
            if (t + 1 < 12) NA_STORE((t + 1) & 1);
            __syncthreads();
        }
        const float inv = 1.0f / l;
        bf16* op = MIX + (size_t)(t0 + 16 * a + n) * D + HW + h * 128 + 4 * g;
#pragma unroll
        for (int vs = 0; vs < 8; ++vs) { const f32x4 v = o[vs] * inv; *(GAS unsigned long long*)(op + 16 * vs) = (unsigned long long)pk2(v[0], v[1]) | ((unsigned long long)pk2(v[2], v[3]) << 32); }
#undef NA_LOAD
#undef NA_STORE
    }
}
__device__ __forceinline__ void readout_simple(Frame& F) {
    const int gw = F.vcu * NWAVES + F.wave, NGW = F.G * NWAVES, lane = F.lane; unsigned char* ws = F.ws;
    const float* OF = (const float*)(ws + WS_MX); const bf16* HG = (const bf16*)(ws + WS_HG); bf16* MIX = (bf16*)(ws + WS_U);
    for (int t = gw; t < T; t += NGW) {
        const size_t o = (size_t)t * HW + 16 * lane; float v[16]; float ss = 0.f;
#pragma unroll
        for (int j = 0; j < 4; ++j) { const f32x4 a = *(const GAS f32x4*)(OF + o + 4 * j), b = *(const GAS f32x4*)(OF + (size_t)T * HW + o + 4 * j);
#pragma unroll
            for (int e = 0; e < 4; ++e) { v[4 * j + e] = a[e] + b[e]; ss += v[4 * j + e] * v[4 * j + e]; } }
        ss += __shfl_xor(ss, 1); ss += __shfl_xor(ss, 2); ss += __shfl_xor(ss, 4);
        const float rs = 1.0f / sqrtf(ss * (1.0f / 128.0f) + EPS);
        const v4u g0 = *(const GAS v4u*)(HG + o), g1 = *(const GAS v4u*)(HG + o + 8);
        const unsigned gw_[8] = {g0.x, g0.y, g0.z, g0.w, g1.x, g1.y, g1.z, g1.w};
        const float* nw = F.in[12] + (16 * lane & 127);
        unsigned ow[8];
#pragma unroll
        for (int j = 0; j < 8; ++j) ow[j] = pk2(v[2 * j] * rs * nw[2 * j] * bflo(gw_[j]), v[2 * j + 1] * rs * nw[2 * j + 1] * bfhi(gw_[j]));
        GAS v4u* mp = (GAS v4u*)(MIX + (size_t)t * D + 16 * lane);
        mp[0] = (v4u){ow[0], ow[1], ow[2], ow[3]}; mp[1] = (v4u){ow[4], ow[5], ow[6], ow[7]};
    }
}

struct Args { const float* in[19]; float* out; unsigned char* ws; int ph_lo, ph_hi; };
__global__ void __launch_bounds__(NWAVES * 64, 2) mk_fwd(Args args) {
    extern __shared__ __attribute__((aligned(16))) unsigned char lds[];
    Frame F;
    F.lds = (LAS unsigned char*)lds;
    F.MISC = (volatile LAS unsigned*)(F.lds + MISC_OFF);
    F.tid = threadIdx.x; F.lane = F.tid & 63; F.wave = __builtin_amdgcn_readfirstlane(F.tid >> 6);
    F.G = gridDim.x; { const int bx = blockIdx.x; F.vcu = (F.G % 8 == 0) ? (bx % 8) * (F.G / 8) + bx / 8 : bx; }
    unsigned char* ws = args.ws; F.ws = ws; F.out = args.out;
#pragma unroll
    for (int i = 0; i < 19; ++i) F.in[i] = args.in[i];
    F.ctl = (gu32*)(ws + WS_CTL);
    for (int u = F.tid; u < 32; u += NWAVES * 64) ((LAS unsigned*)(F.lds + MISC_OFF))[u] = 0u;
    __syncthreads();
    const int lo = args.ph_lo, hi = args.ph_hi;
    XcdBarrier bar; bar.bar = (unsigned*)(F.ctl + CW_BAR); bar.x = 0; bar.st = nullptr;
    if (hi - lo > 1) bar = xcd_barrier_post((unsigned*)(F.ctl + CW_BAR), F.MISC + 8);
#ifndef PROBE_A
#define PROBE_A -1
#define PROBE_B -1
#endif
    unsigned long long tp0 = 0, tpa = 0, tpb = 0; const bool prober = (PROBE_A >= 0) && blockIdx.x == 0 && F.tid == 0;
    if (prober) tp0 = rt();
#define IN(k) ((((k) == PROBE_A && prober) ? (void)(tpa = rt()) : (void)0), (lo <= (k) && (k) < hi))
#define SEAM(k) do { if ((lo <= (k) && (k) < hi) && (lo <= (k) + 1 && (k) + 1 < hi)) xcd_barrier(bar); if ((k) == PROBE_B && prober) tpb = rt(); } while (0)
    const float* mod = (const float*)(ws + WS_MOD);
    bf16* U = (bf16*)(ws + WS_U); bf16* HID = (bf16*)(ws + WS_HID); float* HC = (float*)(ws + WS_HC);

    if (IN(0)) { p0_prologue(F); } SEAM(0);
    if (IN(1)) { norm_mod_phase<false>(F, F.in[0], F.in[2], MT, 0, 0, 1); } SEAM(1);
    if (IN(2)) {
        pg8::Gemm g{U, (const bf16*)(ws + WS_W1), MT, 2 * FF, D}; pg8::StaticOrder S; S.init(MT, 2 * FF, F.G, (int)blockIdx.x);
        pg8::EpiSwiglu E{HID, FF};
        pg8::gemm_phase<pg8::EpiSwiglu, pg8::StaticOrder, true, true>(F.lds + RING_OFF, g, S, E);
        conv_tail(F, (MT / 256) * (2 * FF / 256) % 256, CI_WD1, CI_GU);
    } SEAM(2);
    if (IN(3)) {
        pg8::Gemm g{HID, (const bf16*)(ws + WS_WD1), MT, D, FF}; pg8::OrderDown1 S; S.init(F.G, (int)blockIdx.x);
        pg8::EpiResid E{F.in[0], F.in[2], F.out, (float*)(ws + WS_SLAB), mod + 2 * D, mod + NMOD * D + 2 * D, 0.5f};
        pg8::gemm_phase<pg8::EpiResid, pg8::OrderDown1, true, true>(F.lds + RING_OFF, g, S, E);
        conv_tail(F, 88, CI_WIN, CI_IN + CI_OUT);
    } SEAM(3);
    if (IN(4)) { norm_mod_phase<true>(F, F.out, F.in[2], MT, 1, 3, 4); } SEAM(4);
    if (IN(5)) {
        pg8::Gemm g{U, (const bf16*)(ws + WS_WIN), MT, INC, D}; pg8::StaticOrder S; S.init(MT, INC, F.G, (int)blockIdx.x);
        pg8::EpiWin E{(bf16*)(ws + WS_HQ), (bf16*)(ws + WS_HK0), (bf16*)(ws + WS_HK1), (float*)(ws + WS_LF0), (float*)(ws + WS_LF1), (bf16*)(ws + WS_HV), (bf16*)(ws + WS_HG),
                      (bf16*)(ws + WS_NQ), (bf16*)(ws + WS_NK), (bf16*)(ws + WS_NV), (const float*)(ws + WS_TAB) + 16384, (const float*)(ws + WS_TAB)};
        pg8::gemm_phase<pg8::EpiWin, pg8::StaticOrder, true, true>(F.lds + RING_OFF, g, S, E);
        conv_tail(F, (MT / 256) * (INC / 256) % 256, CI_W2, 2 * CI_GU);
    } SEAM(5);
    if (IN(6)) { for (int it = F.vcu; it < 512; it += F.G) hg_chunk<false>(F, it & 15, it >> 4); } SEAM(6);
    if (IN(7)) { hg_scan(F); na_phase(F, F.vcu, F.G); } SEAM(7);
    if (IN(8)) { for (int it = F.vcu; it < 512; it += F.G) hg_chunk<true>(F, it & 15, 1 + (it >> 4)); } SEAM(8);
    if (IN(9)) { readout_simple(F); } SEAM(9);
    if (IN(10)) {
        pg8::Gemm g{U, (const bf16*)(ws + WS_WOUT), T, D, D}; pg8::StaticOrder S; S.init(T, D, F.G, (int)blockIdx.x);
        pg8::EpiResid E{F.out, F.out, F.out, F.out, mod + 5 * D, mod + 5 * D, 1.0f};
        pg8::gemm_phase<pg8::EpiResid, pg8::StaticOrder, true, true>(F.lds + RING_OFF, g, S, E);
    } SEAM(10);
    if (IN(11)) { norm_mod_phase<false>(F, F.out, F.out, T, 2, 6, 7); } SEAM(11);
    if (IN(12)) {
        pg8::Gemm g{U, (const bf16*)(ws + WS_W2), T, 2 * FF, D}; pg8::StaticOrder S; S.init(T, 2 * FF, F.G, (int)blockIdx.x);
        pg8::EpiSwiglu E{HID, FF};
        pg8::gemm_phase<pg8::EpiSwiglu, pg8::StaticOrder, true, true>(F.lds + RING_OFF, g, S, E);
        conv_tail(F, (T / 256) * (2 * FF / 256) % 256, CI_WD2, CI_GU);
    } SEAM(12);
    if (IN(13)) {
        pg8::Gemm g{HID, (const bf16*)(ws + WS_WD2), T, D, FF}; pg8::StaticOrder S; S.init(T, D, F.G, (int)blockIdx.x);
        pg8::EpiResid E{F.out, F.out, F.out, F.out, mod + 8 * D, mod + 8 * D, 0.5f};
        pg8::gemm_phase<pg8::EpiResid, pg8::StaticOrder, true, true>(F.lds + RING_OFF, g, S, E);
    } SEAM(13);
    if (IN(14)) { final_norm_phase(F); }
    if (14 == PROBE_B && prober) tpb = rt();
    if (prober) { const unsigned long long target = tp0 + 300000ull + 8ull * (tpb - tpa); while (rt() < target) __builtin_amdgcn_s_sleep(32); }
#undef IN
#undef SEAM
}

extern "C" void kernel_launch(void* const* d_in, const int* in_sizes, int n_in, void* d_out, int out_size, void* d_ws, size_t ws_size, hipStream_t stream) {
    static int grid = 0;
    if (grid == 0) {
        if (n_in != 19 || out_size != T * D || ws_size < WS_END) { fprintf(stderr, "kernel_launch: unexpected shapes: n_in %d out %d ws %zu (need %zu)\n", n_in, out_size, ws_size, (size_t)WS_END); grid = -1; return; }
        int dev = 0, cus = 0, per_cu = 0;
        if (hipGetDevice(&dev) != hipSuccess || hipDeviceGetAttribute(&cus, hipDeviceAttributeMultiprocessorCount, dev) != hipSuccess) { grid = -1; return; }
        if (hipFuncSetAttribute((const void*)mk_fwd, hipFuncAttributeMaxDynamicSharedMemorySize, LDS_BYTES) != hipSuccess) { fprintf(stderr, "kernel_launch: hipFuncSetAttribute failed\n"); grid = -1; return; }
        if (hipOccupancyMaxActiveBlocksPerMultiprocessor(&per_cu, (const void*)mk_fwd, NWAVES * 64, LDS_BYTES) != hipSuccess || per_cu < 1) { fprintf(stderr, "kernel_launch: occupancy query says %d\n", per_cu); per_cu = 1; }
        (void)hipGetLastError();
        grid = cus;
    }
    if (grid < 0) return;
    (void)hipMemsetAsync((char*)d_ws + WS_CTL, 0, CTL_ZERO_BYTES, stream);
    Args a{};
    for (int i = 0; i < 19; ++i) a.in[i] = (const float*)d_in[i];
    a.out = (float*)d_out; a.ws = (unsigned char*)d_ws;
    constexpr int NL = MK_N_LAUNCHES;
    for (int li = 0; li < NL; ++li) {
        a.ph_lo = (NL == 1) ? 0 : li; a.ph_hi = (NL == 1) ? N_PHASES : li + 1;
        if (NL == 1) { void* kargs[] = {&a}; hipError_t e = hipLaunchCooperativeKernel((const void*)mk_fwd, dim3(grid), dim3(NWAVES * 64), kargs, LDS_BYTES, stream);
            if (e != hipSuccess) fprintf(stderr, "cooperative launch failed: %s (grid %d)\n", hipGetErrorString(e), grid); }
        else hipLaunchKernelGGL(mk_fwd, dim3(grid), dim3(NWAVES * 64), LDS_BYTES, stream, a);
    }
}
```
